# Optimizing an MI355X kernel written in HIP

```python
import math
import jax, jax.numpy as jnp
from jax import lax
import numpy as np

D_MODEL = 1024
BATCH = 8
SEQ = 4096
DEPTH = 4

CTX_LEN = 256
GRID_W = 64
HEAD_DIM = 64
RWKV_HEADS = D_MODEL // 128
RWKV_WIDTH = RWKV_HEADS * HEAD_DIM
RWKV_W_RANK = 64
RWKV_A_RANK = 64
RWKV_G_RANK = 128
ATTN_Q_HEADS = D_MODEL // HEAD_DIM
ATTN_KV_HEADS = ATTN_Q_HEADS // 4
GQA_GROUP = ATTN_Q_HEADS // ATTN_KV_HEADS
ATTN_Q_WIDTH = ATTN_Q_HEADS * HEAD_DIM
ATTN_KV_WIDTH = ATTN_KV_HEADS * HEAD_DIM
ATTN_SCALE = HEAD_DIM ** -0.5
Q_BLOCK = 128
ROPE_THETA = 10000.0
ROPE_PAIRS = HEAD_DIM // 4
SSM_WIDTH = D_MODEL // 2
SSM_GROUP = 16
SSM_GROUPS = SSM_WIDTH // SSM_GROUP
SSM_STATE = 64
D_FF = 4 * D_MODEL
N_BRANCHES = 3
RWKV_COLS = 3 * RWKV_WIDTH + RWKV_W_RANK + RWKV_A_RANK + RWKV_G_RANK
ATTN_COLS = ATTN_Q_WIDTH + 2 * ATTN_KV_WIDTH
SSM_COLS = SSM_WIDTH
GATE_COLS = N_BRANCHES * D_MODEL
IN_COLS = RWKV_COLS + ATTN_COLS + SSM_COLS + GATE_COLS
COL_SPLITS = [RWKV_COLS, RWKV_COLS + ATTN_COLS, RWKV_COLS + ATTN_COLS + SSM_COLS]
RWKV_SPLITS = [RWKV_WIDTH, 2 * RWKV_WIDTH, 3 * RWKV_WIDTH, 3 * RWKV_WIDTH + RWKV_W_RANK, 3 * RWKV_WIDTH + RWKV_W_RANK + RWKV_A_RANK]
ALPHA = (2 * DEPTH) ** 0.25
BETA = (8 * DEPTH) ** -0.25
LN_EPS = 1e-5
RMS_EPS = 1e-6
GN_EPS = 64e-5

kernel_name = 'hybrid_rwkv7_gqa_s5_dit_block'


def layer_norm(x, g, b):
    xf = x.astype(jnp.float32)
    mu = xf.mean(-1, keepdims=True)
    var = jnp.square(xf - mu).mean(-1, keepdims=True)
    return ((xf - mu) * lax.rsqrt(var + LN_EPS) * g + b).astype(x.dtype)


def rms_norm(x, g):
    xf = x.astype(jnp.float32)
    return (xf * lax.rsqrt(jnp.square(xf).mean(-1, keepdims=True) + RMS_EPS) * g).astype(x.dtype)


def centred_shift(p):
    zero = jnp.zeros_like(p[:, :1])
    prev = jnp.concatenate([zero, p[:, :-1]], axis=1)
    nxt = jnp.concatenate([p[:, 1:], zero], axis=1)
    return 0.5 * (prev + nxt)


def bidir_shared(t):
    return jnp.stack([t, jnp.flip(t, axis=1)])


def bidir_split(t):
    return jnp.stack([t[0], jnp.flip(t[1], axis=1)])


def axial_rope_tables(n_tokens):
    rows = n_tokens // GRID_W
    row = jnp.repeat(jnp.arange(rows, dtype=jnp.float32), GRID_W)
    col = jnp.tile(jnp.arange(GRID_W, dtype=jnp.float32), rows)
    inv = ROPE_THETA ** (-jnp.arange(ROPE_PAIRS, dtype=jnp.float32) / ROPE_PAIRS)
    ang = jnp.stack([row, col], axis=-1)[:, :, None] * inv
    ang = jnp.broadcast_to(ang[:, :, None, :], (n_tokens, 2, 2, ROPE_PAIRS)).reshape(n_tokens, HEAD_DIM)
    return jnp.cos(ang), jnp.sin(ang)


def apply_axial_rope(x, cos, sin):
    xf = x.astype(jnp.float32)
    xr = xf.reshape(*x.shape[:-1], 2, 2, ROPE_PAIRS)
    rot = jnp.stack([-xr[..., 1, :], xr[..., 0, :]], axis=-2).reshape(x.shape)
    return (xf * cos[None, :, None, :] + rot * sin[None, :, None, :]).astype(x.dtype)


def rwkv7_scan(state0, r, decay, k, v, kk, a):
    def step(state, inp):
        r_t, w_t, k_t, v_t, kk_t, a_t = inp
        sa = jnp.einsum('dbhvk,dbhk->dbhv', state, -kk_t)
        state = (state * w_t[..., None, :] + sa[..., :, None] * (kk_t * a_t)[..., None, :]
                 + v_t[..., :, None] * k_t[..., None, :])
        return state, jnp.einsum('dbhvk,dbhk->dbhv', state, r_t)
    xs = tuple(jnp.moveaxis(t.astype(jnp.float32), 2, 0) for t in (r, decay, k, v, kk, a))
    state, ys = lax.scan(step, state0, xs)
    return state, jnp.moveaxis(ys, 0, 2)


def rwkv7_branch(p_lat, p_ctx, mu, w0, w_up, a0, a_up, g_up, k_k, k_a, r_k, gn_w, gn_b, need_ctx_out):
    r_k_h = r_k.reshape(RWKV_HEADS, HEAD_DIM)

    def heads(t):
        return t.reshape(*t.shape[:-1], RWKV_HEADS, HEAD_DIM)

    def prepare(p):
        p = p + mu * (centred_shift(p) - p)
        r, k, v, wd, ad, gd = jnp.split(p, RWKV_SPLITS, axis=-1)
        g = jax.nn.sigmoid(gd) @ g_up
        w_pre = w0[:, None, None, :] + jnp.einsum('btr,drc->dbtc', jnp.tanh(wd), w_up)
        decay = jnp.exp(-jnp.exp(-jax.nn.softplus(-w_pre.astype(jnp.float32)) - 0.5))
        a = jax.nn.sigmoid(a0[:, None, None, :] + jnp.einsum('btr,drc->dbtc', ad, a_up))
        kk = heads(k * k_k).astype(jnp.float32)
        kk = kk * lax.rsqrt(jnp.maximum(jnp.sum(jnp.square(kk), axis=-1, keepdims=True), 1e-24))
        k_dir = k[None] * (1.0 + (a - 1.0) * k_a)
        return heads(r), heads(k_dir), heads(v), kk, heads(decay), heads(a), g

    def readout(ys, r, k_dir, v, g):
        n_b, n_t = g.shape[:2]
        y = ys[0] + jnp.flip(ys[1], axis=1)
        mean = y.mean(-1, keepdims=True)
        var = jnp.square(y - mean).mean(-1, keepdims=True)
        y = ((y - mean) * lax.rsqrt(var + GN_EPS)).reshape(n_b, n_t, RWKV_WIDTH) * gn_w + gn_b
        bonus = jnp.sum(r[None] * k_dir * r_k_h, axis=(0, -1))[..., None] * v
        return ((y + bonus.reshape(n_b, n_t, RWKV_WIDTH)) * g).astype(g.dtype)

    rc, kc, vc, kkc, dc, ac, gc = prepare(p_ctx)
    state0 = jnp.zeros((2, p_ctx.shape[0], RWKV_HEADS, HEAD_DIM, HEAD_DIM), jnp.float32)
    state_ctx, ys_c = rwkv7_scan(state0, bidir_shared(rc), bidir_split(dc), bidir_split(kc),
                                 bidir_shared(vc), bidir_shared(kkc), bidir_split(ac))
    rl, kl, vl, kkl, dl, al, gl = prepare(p_lat)
    _, ys_l = rwkv7_scan(state_ctx, bidir_shared(rl), bidir_split(dl), bidir_split(kl),
                         bidir_shared(vl), bidir_shared(kkl), bidir_split(al))
    y_lat = readout(ys_l, rl, kl, vl, gl)
    y_ctx = readout(ys_c, rc, kc, vc, gc) if need_ctx_out else None
    return y_lat, y_ctx


def grouped_attend(q, k, v):
    s = jnp.einsum('bqhgd,bkhd->bhgqk', q, k).astype(jnp.float32) * ATTN_SCALE
    p = jax.nn.softmax(s, axis=-1).astype(v.dtype)
    return jnp.einsum('bhgqk,bkhd->bqhgd', p, v)


def gqa_axial_branch(p_lat, p_ctx, q_gain, k_gain, cos, sin, need_ctx_out):
    def qkv(p):
        n_b, n_t = p.shape[:2]
        q, k, v = jnp.split(p, [ATTN_Q_WIDTH, ATTN_Q_WIDTH + ATTN_KV_WIDTH], axis=-1)
        q = rms_norm(q.reshape(n_b, n_t, ATTN_Q_HEADS, HEAD_DIM), q_gain)
        k = rms_norm(k.reshape(n_b, n_t, ATTN_KV_HEADS, HEAD_DIM), k_gain)
        return q, k, v.reshape(n_b, n_t, ATTN_KV_HEADS, HEAD_DIM)

    q_c, k_c, v_c = qkv(p_ctx)
    q_l, k_l, v_l = qkv(p_lat)
    q_l = apply_axial_rope(q_l, cos, sin)
    k_l = apply_axial_rope(k_l, cos, sin)
    k_all = jnp.concatenate([k_c, k_l], axis=1)
    v_all = jnp.concatenate([v_c, v_l], axis=1)
    n_b, n_t = q_l.shape[:2]
    q_blocks = q_l.reshape(n_b, n_t // Q_BLOCK, Q_BLOCK, ATTN_KV_HEADS, GQA_GROUP, HEAD_DIM).swapaxes(0, 1)
    o = lax.map(lambda qb: grouped_attend(qb, k_all, v_all), q_blocks)
    y_lat = o.swapaxes(0, 1).reshape(n_b, n_t, ATTN_Q_WIDTH)
    y_ctx = None
    if need_ctx_out:
        n_c = q_c.shape[1]
        y_ctx = grouped_attend(q_c.reshape(n_b, n_c, ATTN_KV_HEADS, GQA_GROUP, HEAD_DIM), k_c, v_c).reshape(n_b, n_c, ATTN_Q_WIDTH)
    return y_lat, y_ctx


def complex_affine_combine(earlier, later):
    a1r, a1i, b1r, b1i = earlier
    a2r, a2i, b2r, b2i = later
    return (a2r * a1r - a2i * a1i, a2r * a1i + a2i * a1r,
            a2r * b1r - a2i * b1i + b2r, a2r * b1i + a2i * b1r + b2i)


def zoh_discretise(a_re, a_im, log_dt):
    lam_re = jnp.minimum(a_re.astype(jnp.float32), -1e-4)
    lam_im = a_im.astype(jnp.float32)
    dt = jnp.exp(log_dt.astype(jnp.float32))[:, None]
    mag = jnp.exp(lam_re * dt)
    abar_re, abar_im = mag * jnp.cos(lam_im * dt), mag * jnp.sin(lam_im * dt)
    nr, ni = abar_re - 1.0, abar_im
    den = jnp.square(lam_re) + jnp.square(lam_im)
    coef_re = (nr * lam_re + ni * lam_im) / den
    coef_im = (ni * lam_re - nr * lam_im) / den
    return abar_re, abar_im, coef_re, coef_im


def s5_scan(bu_re, bu_im, disc, h0, reverse):
    abar_re, abar_im, coef_re, coef_im = disc
    b_re = coef_re * bu_re - coef_im * bu_im
    b_im = coef_re * bu_im + coef_im * bu_re
    if reverse:
        b_re, b_im = jnp.flip(b_re, axis=1), jnp.flip(b_im, axis=1)
    if h0 is not None:
        h_re, h_im = h0
        b_re = b_re.at[:, 0].add(abar_re * h_re - abar_im * h_im)
        b_im = b_im.at[:, 0].add(abar_re * h_im + abar_im * h_re)
    n_t = b_re.shape[1]
    a_r = jnp.broadcast_to(abar_re, (1, n_t, SSM_GROUPS, SSM_STATE))
    a_i = jnp.broadcast_to(abar_im, (1, n_t, SSM_GROUPS, SSM_STATE))
    _, _, x_re, x_im = lax.associative_scan(complex_affine_combine, (a_r, a_i, b_re, b_im), axis=1)
    final = (x_re[:, -1], x_im[:, -1])
    if reverse:
        x_re, x_im = jnp.flip(x_re, axis=1), jnp.flip(x_im, axis=1)
    return x_re, x_im, final


def s5_branch(u_lat, u_ctx, a_re, a_im, log_dt, b_re, b_im, c_re, c_im, d_skip, glu_w, glu_b, need_ctx_out):
    def drive(u):
        ug = u.reshape(u.shape[0], u.shape[1], SSM_GROUPS, SSM_GROUP).astype(jnp.float32)
        return (jnp.einsum('btgi,gni->btgn', ug, b_re.astype(jnp.float32)),
                jnp.einsum('btgi,gni->btgn', ug, b_im.astype(jnp.float32)))

    def readout(x_re, x_im, u):
        y = (jnp.einsum('btgn,gin->btgi', x_re, c_re.astype(jnp.float32))
             - jnp.einsum('btgn,gin->btgi', x_im, c_im.astype(jnp.float32)))
        y = y.reshape(u.shape).astype(u.dtype) + d_skip * u
        y = jax.nn.gelu(y)
        return y * jax.nn.sigmoid(y @ glu_w + glu_b)

    bu_c = drive(u_ctx)
    bu_l = drive(u_lat)
    lat_states, ctx_states = [], []
    for d in range(2):
        disc = zoh_discretise(a_re[d], a_im[d], log_dt[d])
        xc_re, xc_im, h_ctx = s5_scan(bu_c[0], bu_c[1], disc, None, d == 1)
        xl_re, xl_im, _ = s5_scan(bu_l[0], bu_l[1], disc, h_ctx, d == 1)
        lat_states.append((xl_re, xl_im))
        ctx_states.append((xc_re, xc_im))
    y_lat = readout(lat_states[0][0] + lat_states[1][0], lat_states[0][1] + lat_states[1][1], u_lat)
    y_ctx = None
    if need_ctx_out:
        y_ctx = readout(ctx_states[0][0] + ctx_states[1][0], ctx_states[0][1] + ctx_states[1][1], u_ctx)
    return y_lat, y_ctx


def gated_merge(ya, yb, yc, pg, proj_a, proj_b, proj_c, w_out):
    ga, gb, gc = jnp.split(jax.nn.sigmoid(pg), N_BRANCHES, axis=-1)
    merged = ga * (ya @ proj_a) + gb * (yb @ proj_b) + gc * (yc @ proj_c)
    return merged @ w_out


def squared_relu_mlp(h, w1, w2):
    return jnp.square(jax.nn.relu(h @ w1)) @ w2


def setup_inputs(seed: int = 0) -> dict:
    key = jax.random.key(seed)
    ks = iter(jax.random.split(key, 48))

    def nrm(shape, scale):
        return scale * jax.random.normal(next(ks), shape, jnp.float32)

    def unif(shape, lo, hi):
        return jax.random.uniform(next(ks), shape, jnp.float32, minval=lo, maxval=hi)

    L, D = DEPTH, D_MODEL
    n_idx = jnp.arange(SSM_STATE, dtype=jnp.float32)
    return {
        'x': nrm((BATCH, SEQ, D), 1.0),
        'c': nrm((BATCH, D), 1.0),
        'ctx': nrm((BATCH, CTX_LEN, D), 1.0),
        'c_ctx': nrm((D,), 1.0),
        'mod_w': nrm((L, D, 6 * D), 0.5 * D ** -0.5),
        'mod_b': nrm((L, 6 * D), 0.02),
        'w_in': nrm((L, D, IN_COLS), D ** -0.5),
        'rwkv_mu': unif((L, RWKV_COLS), 0.0, 1.0),
        'rwkv_w0': unif((L, 2, RWKV_WIDTH), -6.0, -1.0),
        'rwkv_w_up': nrm((L, 2, RWKV_W_RANK, RWKV_WIDTH), 0.5 * RWKV_W_RANK ** -0.5),
        'rwkv_a0': nrm((L, 2, RWKV_WIDTH), 0.1),
        'rwkv_a_up': nrm((L, 2, RWKV_A_RANK, RWKV_WIDTH), RWKV_A_RANK ** -0.5),
        'rwkv_g_up': nrm((L, RWKV_G_RANK, RWKV_WIDTH), RWKV_G_RANK ** -0.5),
        'rwkv_k_k': 0.85 + nrm((L, RWKV_WIDTH), 0.02),
        'rwkv_k_a': 1.0 + nrm((L, RWKV_WIDTH), 0.02),
        'rwkv_r_k': nrm((L, RWKV_WIDTH), 0.1),
        'rwkv_gn_w': 1.0 + nrm((L, RWKV_WIDTH), 0.02),
        'rwkv_gn_b': nrm((L, RWKV_WIDTH), 0.02),
        'attn_q_gain': 1.0 + nrm((L, HEAD_DIM), 0.02),
        'attn_k_gain': 1.0 + nrm((L, HEAD_DIM), 0.02),
        'ssm_a_re': -0.5 + nrm((L, 2, SSM_GROUPS, SSM_STATE), 0.01),
        'ssm_a_im': jnp.pi * n_idx + nrm((L, 2, SSM_GROUPS, SSM_STATE), 0.01),
        'ssm_log_dt': unif((L, 2, SSM_GROUPS), math.log(1e-3), math.log(1e-1)),
        'ssm_b_re': nrm((L, SSM_GROUPS, SSM_STATE, SSM_GROUP), (2 * SSM_GROUP) ** -0.5),
        'ssm_b_im': nrm((L, SSM_GROUPS, SSM_STATE, SSM_GROUP), (2 * SSM_GROUP) ** -0.5),
        'ssm_c_re': nrm((L, SSM_GROUPS, SSM_GROUP, SSM_STATE), 0.5),
        'ssm_c_im': nrm((L, SSM_GROUPS, SSM_GROUP, SSM_STATE), 0.5),
        'ssm_d': nrm((L, SSM_WIDTH), 0.5),
        'ssm_glu_w': nrm((L, SSM_WIDTH, SSM_WIDTH), SSM_WIDTH ** -0.5),
        'ssm_glu_b': nrm((L, SSM_WIDTH), 0.02),
        'proj_a': nrm((L, RWKV_WIDTH, D), RWKV_WIDTH ** -0.5),
        'proj_b': nrm((L, ATTN_Q_WIDTH, D), ATTN_Q_WIDTH ** -0.5),
        'proj_c': nrm((L, SSM_WIDTH, D), SSM_WIDTH ** -0.5),
        'w_out': nrm((L, D, D), BETA * D ** -0.5),
        'ln1_g': 1.0 + nrm((L, D), 0.02),
        'ln1_b': nrm((L, D), 0.02),
        'ln2_g': 1.0 + nrm((L, D), 0.02),
        'ln2_b': nrm((L, D), 0.02),
        'mlp_w1': nrm((L, D, D_FF), D ** -0.5),
        'mlp_w2': nrm((L, D_FF, D), BETA * D_FF ** -0.5),
    }


def reference(x, c, ctx, c_ctx, mod_w, mod_b, w_in, rwkv_mu, rwkv_w0, rwkv_w_up, rwkv_a0, rwkv_a_up, rwkv_g_up,
              rwkv_k_k, rwkv_k_a, rwkv_r_k, rwkv_gn_w, rwkv_gn_b, attn_q_gain, attn_k_gain, ssm_a_re, ssm_a_im,
              ssm_log_dt, ssm_b_re, ssm_b_im, ssm_c_re, ssm_c_im, ssm_d, ssm_glu_w, ssm_glu_b, proj_a, proj_b, proj_c,
              w_out, ln1_g, ln1_b, ln2_g, ln2_b, mlp_w1, mlp_w2):
    cos, sin = axial_rope_tables(x.shape[1])
    c_silu = jax.nn.silu(c)
    cc_silu = jax.nn.silu(c_ctx)
    xc = ctx
    for l in range(DEPTH):
        update_ctx = l < DEPTH - 1
        sh1, sc1, gt1, sh2, sc2, gt2 = jnp.split((c_silu @ mod_w[l] + mod_b[l])[:, None, :], 6, axis=-1)
        sh1c, sc1c, gt1c, sh2c, sc2c, gt2c = jnp.split(cc_silu @ mod_w[l] + mod_b[l], 6, axis=-1)
        proj = (x * (1.0 + sc1) + sh1) @ w_in[l]
        proj_ctx = (xc * (1.0 + sc1c) + sh1c) @ w_in[l]
        pa, pb, pc, pg = jnp.split(proj, COL_SPLITS, axis=-1)
        pa_c, pb_c, pc_c, pg_c = jnp.split(proj_ctx, COL_SPLITS, axis=-1)
        ya, ya_c = rwkv7_branch(pa, pa_c, rwkv_mu[l], rwkv_w0[l], rwkv_w_up[l], rwkv_a0[l], rwkv_a_up[l],
                                rwkv_g_up[l], rwkv_k_k[l], rwkv_k_a[l], rwkv_r_k[l], rwkv_gn_w[l], rwkv_gn_b[l],
                                update_ctx)
        yb, yb_c = gqa_axial_branch(pb, pb_c, attn_q_gain[l], attn_k_gain[l], cos, sin, update_ctx)
        yc, yc_c = s5_branch(pc, pc_c, ssm_a_re[l], ssm_a_im[l], ssm_log_dt[l], ssm_b_re[l], ssm_b_im[l],
                             ssm_c_re[l], ssm_c_im[l], ssm_d[l], ssm_glu_w[l], ssm_glu_b[l], update_ctx)
        mix = gated_merge(ya, yb, yc, pg, proj_a[l], proj_b[l], proj_c[l], w_out[l])
        x_mid = layer_norm(ALPHA * x + gt1 * mix, ln1_g[l], ln1_b[l])
        ff = squared_relu_mlp(x_mid * (1.0 + sc2) + sh2, mlp_w1[l], mlp_w2[l])
        x = layer_norm(ALPHA * x_mid + gt2 * ff, ln2_g[l], ln2_b[l])
        if update_ctx:
            mix_c = gated_merge(ya_c, yb_c, yc_c, pg_c, proj_a[l], proj_b[l], proj_c[l], w_out[l])
            xc_mid = layer_norm(ALPHA * xc + gt1c * mix_c, ln1_g[l], ln1_b[l])
            ff_c = squared_relu_mlp(xc_mid * (1.0 + sc2c) + sh2c, mlp_w1[l], mlp_w2[l])
            xc = layer_norm(ALPHA * xc_mid + gt2c * ff_c, ln2_g[l], ln2_b[l])
    return x
```

```cpp
#include <hip/hip_runtime.h>
#include <hip/hip_cooperative_groups.h>
#include <cstdio>
#include <cstdint>
namespace cg = cooperative_groups;

#ifndef MULTI_LAUNCH
#define MULTI_LAUNCH 0
#endif

#define DI __device__ __forceinline__
typedef __attribute__((ext_vector_type(8))) short bf16x8;
typedef __attribute__((ext_vector_type(4))) short bf16x4;
typedef __attribute__((ext_vector_type(16))) float f32x16;
typedef __attribute__((ext_vector_type(4))) float f32x4;
typedef __attribute__((ext_vector_type(2))) float f2;
typedef __attribute__((ext_vector_type(2))) __bf16 bf2;
typedef unsigned short u16;
typedef __attribute__((ext_vector_type(4))) unsigned int u32x4;

constexpr int NB = 8, SEQ = 4096, CTXL = 256, TPB = 4352, NTOK = NB * TPB, DM = 1024, DEPTH = 4;
constexpr int PW = 3840;
constexpr int PC_R = 0, PC_K = 512, PC_V = 1024, PC_WD = 1536, PC_AD = 1600, PC_GD = 1664, PC_Q = 1792, PC_KK = 2816, PC_VV = 3072, PC_U = 3328;
constexpr int IN_COLS = 6912, GATE_OFF = 3840, DFF = 4096;
constexpr int NTHREADS = 256;
constexpr int SMEM_BYTES = 73728;
constexpr float ALPHA = 1.681792830507429f;
constexpr float QSCALE = 0.125f * 1.4426950408889634f;
constexpr int NROWT = NTOK / 128;
#define XCD_BAR_WORDS 3456
constexpr int NSUB = 9;
constexpr int NPHASES = 2 + NSUB * DEPTH + 1;
constexpr int W_IN = 0, W_PA = 7077888, W_PB = 7602176, W_PC = 8650752, W_OUT = 9175040, W_1 = 10223616, W_2 = 14417920, W_GUP = 18612224, W_GLU = 18677760, W_TOTAL = 18939904;

struct Params {
  const float *x, *c, *ctx, *c_ctx, *mod_w, *mod_b, *w_in, *rwkv_mu, *rwkv_w0, *rwkv_w_up, *rwkv_a0, *rwkv_a_up, *rwkv_g_up,
      *rwkv_k_k, *rwkv_k_a, *rwkv_r_k, *rwkv_gn_w, *rwkv_gn_b, *attn_q_gain, *attn_k_gain, *ssm_a_re, *ssm_a_im, *ssm_log_dt,
      *ssm_b_re, *ssm_b_im, *ssm_c_re, *ssm_c_im, *ssm_d, *ssm_glu_w, *ssm_glu_b, *proj_a, *proj_b, *proj_c, *w_out,
      *ln1_g, *ln1_b, *ln2_g, *ln2_b, *mlp_w1, *mlp_w2;
  float* out;
  float* X; u16* P; u16* Vt; u16* R2; u16* S5S; float* modv; float* modpart; float* stats1; float* stats2; float* bonus; float* rope; int* ctr; u16* WB; u16* XN; unsigned* bar; int* cuc;
  int phase_begin, phase_end;
};

DI int ltid() { int t = threadIdx.x; asm volatile("" : "+v"(t)); return t; }
DI u16 f2bf(float f) { unsigned u = __float_as_uint(f); u += 0x7fffu + ((u >> 16) & 1u); return (u16)(u >> 16); }
DI float bf2f(u16 v) { return __uint_as_float(((unsigned)v) << 16); }
DI unsigned pack2(float a, float b) { f2 v = {a, b}; bf2 c = __builtin_convertvector(v, bf2); return __builtin_bit_cast(unsigned, c); }
DI float sigm(float x) { return __builtin_amdgcn_rcpf(1.f + __expf(-x)); }
DI float tanh_fast(float x) { float e = __expf(2.f * x); return 1.f - 2.f * __builtin_amdgcn_rcpf(1.f + e); }
DI float softplus_fast(float x) { return fmaxf(x, 0.f) + __logf(1.f + __expf(-fabsf(x))); }
DI float wave_sum(float v) {
#pragma unroll
  for (int o = 32; o > 0; o >>= 1) v += __shfl_xor(v, o);
  return v;
}
DI float fma_s(float a, float b, float c) { float d; asm("v_fma_f32 %0, %1, %2, %3" : "=v"(d) : "v"(a), "v"(b), "v"(c)); return d; }
DI float mul_s(float a, float b) { float d; asm("v_mul_f32 %0, %1, %2" : "=v"(d) : "v"(a), "v"(b)); return d; }
DI float dot8_s(const float (&S)[8], float n0, float n1, float n2, float n3, float n4, float n5, float n6, float n7) {
  float pa, pb;
  asm("v_mul_f32 %0, %2, %10\n\t"
      "v_mul_f32 %1, %3, %11\n\t"
      "v_fma_f32 %0, %4, %12, %0\n\t"
      "v_fma_f32 %1, %5, %13, %1\n\t"
      "v_fma_f32 %0, %6, %14, %0\n\t"
      "v_fma_f32 %1, %7, %15, %1\n\t"
      "v_fma_f32 %0, %8, %16, %0\n\t"
      "v_fma_f32 %1, %9, %17, %1\n\t"
      "v_add_f32 %0, %0, %1"
      : "=&v"(pa), "=&v"(pb)
      : "v"(S[0]), "v"(S[1]), "v"(S[2]), "v"(S[3]), "v"(S[4]), "v"(S[5]), "v"(S[6]), "v"(S[7]),
        "v"(n0), "v"(n1), "v"(n2), "v"(n3), "v"(n4), "v"(n5), "v"(n6), "v"(n7));
  return pa;
}
DI void upd4_s(float& s0, float& s1, float& s2, float& s3, float vv, float sa,
               float kd0, float kd1, float kd2, float kd3, float ka0, float ka1, float ka2, float ka3,
               float w0, float w1, float w2, float w3) {
  float t0, t1;
  asm("v_mul_f32 %4, %6, %8\n\t"
      "v_mul_f32 %5, %6, %9\n\t"
      "v_fma_f32 %4, %7, %12, %4\n\t"
      "v_fma_f32 %5, %7, %13, %5\n\t"
      "v_fma_f32 %0, %0, %16, %4\n\t"
      "v_fma_f32 %1, %1, %17, %5\n\t"
      "v_mul_f32 %4, %6, %10\n\t"
      "v_mul_f32 %5, %6, %11\n\t"
      "v_fma_f32 %4, %7, %14, %4\n\t"
      "v_fma_f32 %5, %7, %15, %5\n\t"
      "v_fma_f32 %2, %2, %18, %4\n\t"
      "v_fma_f32 %3, %3, %19, %5"
      : "+v"(s0), "+v"(s1), "+v"(s2), "+v"(s3), "=&v"(t0), "=&v"(t1)
      : "v"(vv), "v"(sa), "v"(kd0), "v"(kd1), "v"(kd2), "v"(kd3), "v"(ka0), "v"(ka1), "v"(ka2), "v"(ka3),
        "v"(w0), "v"(w1), "v"(w2), "v"(w3));
}
DI int crow(int i, int h) { return (i & 3) + 8 * (i >> 2) + 4 * h; }
#define MFMA32(a, b, c) __builtin_amdgcn_mfma_f32_32x32x16_bf16((a), (b), (c), 0, 0, 0)
#define MFMA16(a, b, c) __builtin_amdgcn_mfma_f32_16x16x32_bf16((a), (b), (c), 0, 0, 0)

DI float lerpP(const u16* Prow, int col, bool hp, bool hn, float mu) {
  float x = bf2f(Prow[col]);
  float xp = hp ? bf2f(Prow[col - PW]) : 0.f;
  float xn = hn ? bf2f(Prow[col + PW]) : 0.f;
  return x + mu * (0.5f * (xp + xn) - x);
}

DI void unpack8(const uint4 q, float (&o)[8]) {
  o[0] = __uint_as_float(q.x << 16); o[1] = __uint_as_float(q.x & 0xffff0000u);
  o[2] = __uint_as_float(q.y << 16); o[3] = __uint_as_float(q.y & 0xffff0000u);
  o[4] = __uint_as_float(q.z << 16); o[5] = __uint_as_float(q.z & 0xffff0000u);
  o[6] = __uint_as_float(q.w << 16); o[7] = __uint_as_float(q.w & 0xffff0000u);
}
DI void lerp8(const u16* prow, int col, bool hp, bool hn, const float* mu, float (&o)[8]) {
  float x[8], xp[8], xn[8];
  unpack8(*(const uint4*)(prow + col), x);
  uint4 z = make_uint4(0, 0, 0, 0);
  unpack8(hp ? *(const uint4*)(prow + col - PW) : z, xp);
  unpack8(hn ? *(const uint4*)(prow + col + PW) : z, xn);
  float4 m0 = *(const float4*)(mu + col), m1 = *(const float4*)(mu + col + 4);
  float m[8] = {m0.x, m0.y, m0.z, m0.w, m1.x, m1.y, m1.z, m1.w};
#pragma unroll
  for (int i = 0; i < 8; ++i) o[i] = x[i] + m[i] * (0.5f * (xp[i] + xn[i]) - x[i]);
}

constexpr int GROW = 144;
constexpr int GTILE = 128 * GROW;

enum { AK_BF16 = 1, AK_GD = 2 };

struct ASrc {
  const u16* A16;
  int lda;
  const float* mu;
  int m0;
};

template <int AK>
DI void gemm_main(f32x16 (&acc)[2][2], const ASrc& as, const u16* __restrict__ BT, int ldbt, int K, char* smem) {
  const int tid = ltid(), wave = tid >> 6, lane = tid & 63, r = lane & 31, h = lane >> 5;
  const int wm = wave >> 1, wn = wave & 1;
  const int lrow = tid >> 3, lseg = tid & 7;
  const int grow = tid >> 1, ghalf = tid & 1;
  bool hp = false, hn = false;
  if (AK == AK_GD) {
    int s = (as.m0 + grow) % TPB;
    int pos = s < CTXL ? s : s - CTXL, len = s < CTXL ? CTXL : SEQ;
    hp = pos > 0; hn = pos < len - 1;
  }
  const u16* aptr = (AK == AK_BF16) ? as.A16 + (size_t)lrow * as.lda + lseg * 8 : as.A16 + (size_t)grow * PW;
  const u16* bptr = BT + (size_t)lrow * ldbt + lseg * 8;
  const size_t astep = (size_t)32 * as.lda, bstep = (size_t)32 * ldbt;
  char* const sa = smem + ((AK == AK_BF16) ? lrow * GROW + lseg * 16 : grow * GROW + ghalf * 64);
  char* const sb = smem + 2 * GTILE + lrow * GROW + lseg * 16;
  u32x4 a0_0, a0_1, a0_2, a0_3, b0_0, b0_1, b0_2, b0_3, a1_0, a1_1, a1_2, a1_3, b1_0, b1_1, b1_2, b1_3;
#define G_GD1(dst, k0, i)                                                                          \
  {                                                                                                \
    float o_[8];                                                                                   \
    lerp8(aptr, PC_GD + (k0) + ghalf * 32 + 8 * (i), hp, hn, as.mu, o_);                           \
    dst.x = pack2(sigm(o_[0]), sigm(o_[1])); dst.y = pack2(sigm(o_[2]), sigm(o_[3]));              \
    dst.z = pack2(sigm(o_[4]), sigm(o_[5])); dst.w = pack2(sigm(o_[6]), sigm(o_[7]));              \
  }
#define G_LOAD(RA, RB, k0)                                                                         \
  {                                                                                                \
    if (AK == AK_BF16) {                                                                           \
      RA##_0 = *(const u32x4*)(aptr + (k0));                                                       \
      RA##_1 = *(const u32x4*)(aptr + astep + (k0));                                               \
      RA##_2 = *(const u32x4*)(aptr + 2 * astep + (k0));                                           \
      RA##_3 = *(const u32x4*)(aptr + 3 * astep + (k0));                                           \
    } else {                                                                                       \
      G_GD1(RA##_0, k0, 0) G_GD1(RA##_1, k0, 1) G_GD1(RA##_2, k0, 2) G_GD1(RA##_3, k0, 3)          \
    }                                                                                              \
    RB##_0 = *(const u32x4*)(bptr + (k0));                                                         \
    RB##_1 = *(const u32x4*)(bptr + bstep + (k0));                                                 \
    RB##_2 = *(const u32x4*)(bptr + 2 * bstep + (k0));                                             \
    RB##_3 = *(const u32x4*)(bptr + 3 * bstep + (k0));                                             \
  }
#define G_STORE(RA, RB, buf)                                                                       \
  {                                                                                                \
    constexpr int AS_ = (AK == AK_BF16) ? 32 * GROW : 16;                                          \
    *(u32x4*)(sa + (buf) * GTILE) = RA##_0;                                                        \
    *(u32x4*)(sa + (buf) * GTILE + AS_) = RA##_1;                                                  \
    *(u32x4*)(sa + (buf) * GTILE + 2 * AS_) = RA##_2;                                              \
    *(u32x4*)(sa + (buf) * GTILE + 3 * AS_) = RA##_3;                                              \
    *(u32x4*)(sb + (buf) * GTILE) = RB##_0;                                                        \
    *(u32x4*)(sb + (buf) * GTILE + 32 * GROW) = RB##_1;                                            \
    *(u32x4*)(sb + (buf) * GTILE + 64 * GROW) = RB##_2;                                            \
    *(u32x4*)(sb + (buf) * GTILE + 96 * GROW) = RB##_3;                                            \
  }
#define G_COMPUTE(buf)                                                                             \
  {                                                                                                \
    const char* Ab = smem + (buf) * GTILE + (wm * 64 + r) * GROW + h * 16;                         \
    const char* Bb = smem + 2 * GTILE + (buf) * GTILE + (wn * 64 + r) * GROW + h * 16;             \
    __builtin_amdgcn_s_setprio(1);     \
    _Pragma("unroll") for (int k2 = 0; k2 < 4; ++k2) {                                             \
      bf16x8 fa0 = *(const bf16x8*)(Ab + k2 * 32);                                                 \
      bf16x8 fa1 = *(const bf16x8*)(Ab + 32 * GROW + k2 * 32);                                     \
      bf16x8 fb0 = *(const bf16x8*)(Bb + k2 * 32);                                                 \
      bf16x8 fb1 = *(const bf16x8*)(Bb + 32 * GROW + k2 * 32);                                     \
      acc[0][0] = MFMA32(fa0, fb0, acc[0][0]);                                                     \
      acc[0][1] = MFMA32(fa0, fb1, acc[0][1]);                                                     \
      acc[1][0] = MFMA32(fa1, fb0, acc[1][0]);                                                     \
      acc[1][1] = MFMA32(fa1, fb1, acc[1][1]);                                                     \
    }                                                                                              \
    __builtin_amdgcn_s_setprio(0);                                                                 \
  }
  const int nk = K >> 6;
  __syncthreads();
  G_LOAD(a0, b0, 0);
  G_STORE(a0, b0, 0);
  G_LOAD(a1, b1, 64);
  if (nk > 2) G_LOAD(a0, b0, 128);
  __syncthreads();
  int ks = 0;
#pragma unroll 1
  for (; ks + 6 <= nk; ks += 2) {
    G_COMPUTE(0);
    G_STORE(a1, b1, 1);
    G_LOAD(a1, b1, (ks + 3) * 64);
    __syncthreads();
    G_COMPUTE(1);
    G_STORE(a0, b0, 0);
    G_LOAD(a0, b0, (ks + 4) * 64);
    __syncthreads();
  }
  if (ks + 4 <= nk) {
    G_COMPUTE(0);
    G_STORE(a1, b1, 1);
    G_LOAD(a1, b1, (ks + 3) * 64);
    __syncthreads();
    G_COMPUTE(1);
    G_STORE(a0, b0, 0);
    __syncthreads();
    ks += 2;
  }
  G_COMPUTE(0);
  G_STORE(a1, b1, 1);
  __syncthreads();
  G_COMPUTE(1);
  __syncthreads();
#undef G_LOAD
#undef G_GD1
#undef G_STORE
#undef G_COMPUTE
}

DI void zero_acc(f32x16 (&acc)[2][2]) {
#pragma unroll
  for (int a = 0; a < 2; ++a)
#pragma unroll
    for (int b = 0; b < 2; ++b)
#pragma unroll
      for (int i = 0; i < 16; ++i) acc[a][b][i] = 0.f;
}

DI void stage_half(const f32x16 (&acc)[2][2], int hf, char* smem) {
  const int tid = ltid(), wave = tid >> 6, lane = tid & 63, r = lane & 31, h = lane >> 5;
  const int wm = wave >> 1, wn = wave & 1;
  float* st = (float*)smem;
  __syncthreads();
  if (wm == hf) {
#pragma unroll
    for (int mt = 0; mt < 2; ++mt)
#pragma unroll
      for (int nt = 0; nt < 2; ++nt)
#pragma unroll
        for (int i = 0; i < 16; ++i) st[(mt * 32 + crow(i, h)) * 132 + wn * 64 + nt * 32 + r] = acc[mt][nt][i];
  }
  __syncthreads();
}
DI void read_staged(float (&v)[32], char* smem) {
  const int tid = ltid();
  const float4* src = (const float4*)((float*)smem + (tid >> 2) * 132 + (tid & 3) * 32);
#pragma unroll
  for (int i = 0; i < 8; ++i) { float4 q = src[i]; v[4 * i] = q.x; v[4 * i + 1] = q.y; v[4 * i + 2] = q.z; v[4 * i + 3] = q.w; }
}
DI void store_bf16_32(u16* dst, const float (&v)[32]) {
  uint4* d = (uint4*)dst;
#pragma unroll
  for (int i = 0; i < 4; ++i) {
    uint4 o;
    o.x = pack2(v[8 * i], v[8 * i + 1]); o.y = pack2(v[8 * i + 2], v[8 * i + 3]);
    o.z = pack2(v[8 * i + 4], v[8 * i + 5]); o.w = pack2(v[8 * i + 6], v[8 * i + 7]);
    d[i] = o;
  }
}
DI void row_stats(const float* stats, int R, float& mean, float& rstd) {
  const float4* sp = (const float4*)(stats + (size_t)R * 16);
  float s0 = 0.f, s1 = 0.f;
#pragma unroll
  for (int i = 0; i < 4; ++i) { float4 q = sp[i]; s0 += q.x + q.z; s1 += q.y + q.w; }
  mean = s0 * (1.f / 1024.f);
  float var = s1 * (1.f / 1024.f) - mean * mean;
  rstd = rsqrtf(fmaxf(var, 0.f) + 1e-5f);
}
DI int mod_index(int rt) { int b = rt / 34, tin = rt % 34; return tin < 2 ? 8 : b; }

DI void phase_init0(const Params& p, char* smem) {
  const int tid = ltid();
  for (int i = blockIdx.x * NTHREADS + tid; i < DEPTH * 4096; i += gridDim.x * NTHREADS) p.cuc[i] = 0;
  if (blockIdx.x == 0) {
    if (tid < 64) p.ctr[tid] = 0;
    for (int i = tid; i < XCD_BAR_WORDS; i += NTHREADS) p.bar[i] = 0u;
    for (int i = tid; i < 64 * 16; i += NTHREADS) {
      int pos = i >> 4, pp = i & 15;
      float inv = powf(10000.f, -(float)pp / 16.f);
      float ang = (float)pos * inv;
      p.rope[i] = cosf(ang);
      p.rope[1024 + i] = sinf(ang);
    }
  }
  float* sc = (float*)smem;
  for (int task = blockIdx.x; task < DEPTH * 24 * 8; task += gridDim.x) {
    int kc = task & 7, jb = (task >> 3) % 24, l = task / (24 * 8);
    __syncthreads();
    for (int i = tid; i < 9 * 128; i += NTHREADS) {
      int mi = i >> 7, k = kc * 128 + (i & 127);
      float v = mi < 8 ? p.c[mi * 1024 + k] : p.c_ctx[k];
      sc[i] = v * sigm(v);
    }
    __syncthreads();
    int j = jb * 256 + tid;
    float a[9];
#pragma unroll
    for (int mi = 0; mi < 9; ++mi) a[mi] = 0.f;
    const float* w = p.mod_w + ((size_t)l * 1024 + kc * 128) * 6144 + j;
#pragma unroll 8
    for (int k = 0; k < 128; ++k) {
      float wv = w[(size_t)k * 6144];
#pragma unroll
      for (int mi = 0; mi < 9; ++mi) a[mi] += sc[mi * 128 + k] * wv;
    }
#pragma unroll
    for (int mi = 0; mi < 9; ++mi) p.modpart[(((size_t)kc * DEPTH + l) * 9 + mi) * 6144 + j] = a[mi];
  }
}
DI void phase_init1(const Params& p) {
  const int n = DEPTH * 9 * 6144;
  for (int i = blockIdx.x * NTHREADS + ltid(); i < n; i += gridDim.x * NTHREADS) {
    int j = i % 6144, l = i / (9 * 6144);
    float s = p.mod_b[l * 6144 + j];
#pragma unroll
    for (int kc = 0; kc < 8; ++kc) s += p.modpart[(size_t)kc * n + i];
    p.modv[i] = s;
  }
}

DI const float* in_row(const Params& p, int R) {
  const int b = R / TPB, s = R % TPB;
  return s < CTXL ? p.ctx + ((size_t)b * CTXL + s) * 1024 : p.x + ((size_t)b * SEQ + (s - CTXL)) * 1024;
}
DI void xn_phase(const Params& p, const float* stats, const float* g, const float* bta, int l, int sc_off, int sh_off) {
  const int tid = ltid(), wave = tid >> 6, lane = tid & 63;
  for (int row = blockIdx.x * 4 + wave; row < NTOK; row += gridDim.x * 4) {
    const int b = row / TPB, s = row % TPB;
    const int mi = s < CTXL ? 8 : b;
    const float* mv = p.modv + ((size_t)l * 9 + mi) * 6144;
    const f32x4* xr = (const f32x4*)(stats ? p.X + (size_t)row * 1024 : in_row(p, row));
    const f32x4 xv0 = xr[lane], xv1 = xr[lane + 64], xv2 = xr[lane + 128], xv3 = xr[lane + 192];
    float mean = 0.f, rstd = 1.f;
    if (stats) row_stats(stats, row, mean, rstd);
    uint2* dst = (uint2*)(p.XN + (size_t)row * 1024);
#pragma unroll
    for (int j = 0; j < 4; ++j) {
      const int c4 = lane + 64 * j;
      const f32x4 vq = j == 0 ? xv0 : (j == 1 ? xv1 : (j == 2 ? xv2 : xv3));
      float4 v = make_float4(vq.x, vq.y, vq.z, vq.w);
      if (stats) {
        float4 gv = ((const float4*)g)[c4], bv = ((const float4*)bta)[c4];
        v.x = (v.x - mean) * rstd * gv.x + bv.x; v.y = (v.y - mean) * rstd * gv.y + bv.y;
        v.z = (v.z - mean) * rstd * gv.z + bv.z; v.w = (v.w - mean) * rstd * gv.w + bv.w;
      }
      float4 sc = ((const float4*)(mv + sc_off))[c4], sh = ((const float4*)(mv + sh_off))[c4];
      uint2 o;
      o.x = pack2(v.x * (1.f + sc.x) + sh.x, v.y * (1.f + sc.y) + sh.y);
      o.y = pack2(v.z * (1.f + sc.z) + sh.z, v.w * (1.f + sc.w) + sh.w);
      dst[c4] = o;
    }
  }
}
DI void wconv_phase(const Params& p, int l, char* smem) {
  const int tid = ltid();
  float* tl = (float*)smem;
  constexpr int NT = 1728 + 128 + 256 + 128 + 256 + 1024 + 1024 + 16 + 64;
  for (int t = blockIdx.x; t < NT; t += gridDim.x) {
    const float* src; int K, N, doff, tt = t;
    if (tt < 1728) { src = p.w_in + (size_t)l * 1024 * IN_COLS; K = 1024; N = IN_COLS; doff = W_IN; }
    else if ((tt -= 1728) < 128) { src = p.proj_a + (size_t)l * 512 * 1024; K = 512; N = 1024; doff = W_PA; }
    else if ((tt -= 128) < 256) { src = p.proj_b + (size_t)l * 1024 * 1024; K = 1024; N = 1024; doff = W_PB; }
    else if ((tt -= 256) < 128) { src = p.proj_c + (size_t)l * 512 * 1024; K = 512; N = 1024; doff = W_PC; }
    else if ((tt -= 128) < 256) { src = p.w_out + (size_t)l * 1024 * 1024; K = 1024; N = 1024; doff = W_OUT; }
    else if ((tt -= 256) < 1024) { src = p.mlp_w1 + (size_t)l * 1024 * DFF; K = 1024; N = DFF; doff = W_1; }
    else if ((tt -= 1024) < 1024) { src = p.mlp_w2 + (size_t)l * DFF * 1024; K = DFF; N = 1024; doff = W_2; }
    else if ((tt -= 1024) < 16) { src = p.rwkv_g_up + (size_t)l * 128 * 512; K = 128; N = 512; doff = W_GUP; }
    else { tt -= 16; src = p.ssm_glu_w + (size_t)l * 512 * 512; K = 512; N = 512; doff = W_GLU; }
    const int ntn = N >> 6;
    const int k0 = (tt / ntn) * 64, n0 = (tt % ntn) * 64;
    __syncthreads();
#pragma unroll
    for (int i = 0; i < 4; ++i) {
      int k = (tid >> 4) + 16 * i, n4 = (tid & 15) * 4;
      float4 v = *(const float4*)(src + (size_t)(k0 + k) * N + n0 + n4);
      tl[k * 65 + n4] = v.x; tl[k * 65 + n4 + 1] = v.y; tl[k * 65 + n4 + 2] = v.z; tl[k * 65 + n4 + 3] = v.w;
    }
    __syncthreads();
    const int n = tid >> 2, kseg = (tid & 3) * 16;
    uint4 o0, o1;
    o0.x = pack2(tl[(kseg + 0) * 65 + n], tl[(kseg + 1) * 65 + n]); o0.y = pack2(tl[(kseg + 2) * 65 + n], tl[(kseg + 3) * 65 + n]);
    o0.z = pack2(tl[(kseg + 4) * 65 + n], tl[(kseg + 5) * 65 + n]); o0.w = pack2(tl[(kseg + 6) * 65 + n], tl[(kseg + 7) * 65 + n]);
    o1.x = pack2(tl[(kseg + 8) * 65 + n], tl[(kseg + 9) * 65 + n]); o1.y = pack2(tl[(kseg + 10) * 65 + n], tl[(kseg + 11) * 65 + n]);
    o1.z = pack2(tl[(kseg + 12) * 65 + n], tl[(kseg + 13) * 65 + n]); o1.w = pack2(tl[(kseg + 14) * 65 + n], tl[(kseg + 15) * 65 + n]);
    uint4* dst = (uint4*)(p.WB + doff + (size_t)(n0 + n) * K + k0 + kseg);
    dst[0] = o0; dst[1] = o1;
  }
}

DI void phaseA_tile(const Params& p, int l, int t, char* smem) {
  const int rt = t / 30, ct = t % 30, m0 = rt * 128, n0 = ct * 128;
  const int tid = ltid();
  const int mi = mod_index(rt);
  const float* mv = p.modv + ((size_t)l * 9 + mi) * 6144;
  f32x16 acc[2][2];
  zero_acc(acc);
  ASrc as{};
  as.A16 = p.XN + (size_t)m0 * 1024; as.lda = 1024; as.m0 = m0;
  gemm_main<AK_BF16>(acc, as, p.WB + W_IN + (size_t)n0 * 1024, 1024, 1024, smem);
  const int b = rt / 34;
#pragma unroll 1
  for (int hf = 0; hf < 2; ++hf) {
    stage_half(acc, hf, smem);
    if (ct == 24 || ct == 25) {
      const int col = tid & 127, grp = tid >> 7;
      const float* st = (const float*)smem;
      float v[32];
#pragma unroll
      for (int i = 0; i < 32; ++i) v[i] = st[(grp * 32 + i) * 132 + col];
      const int vcol = n0 - PC_VV + col, kvh = vcol >> 6, d = vcol & 63;
      const int s0 = m0 + hf * 64 - b * TPB + grp * 32;
      store_bf16_32(p.Vt + ((size_t)(b * 4 + kvh) * 64 + d) * TPB + s0, v);
    } else {
      float v[32];
      read_staged(v, smem);
      const int R = m0 + hf * 64 + (tid >> 2);
      const int col0 = n0 + (tid & 3) * 32;
      if (ct >= 14 && ct < 24) {
        const bool isq = ct < 22;
        const int hd = (col0 - PC_Q) & 63;
        float ss = 0.f;
#pragma unroll
        for (int i = 0; i < 32; ++i) ss += v[i] * v[i];
        ss += __shfl_xor(ss, 1);
        float rinv = rsqrtf(ss * (1.f / 64.f) + 1e-6f);
        const float* gain = (isq ? p.attn_q_gain : p.attn_k_gain) + l * 64 + hd;
#pragma unroll
        for (int i = 0; i < 32; ++i) v[i] = v[i] * rinv * gain[i];
        const int s = R % TPB;
        if (s >= CTXL) {
          const int tt = s - CTXL;
          const int pos = (hd == 0) ? (tt >> 6) : (tt & 63);
          const float* rc = p.rope + pos * 16;
#pragma unroll
          for (int i = 0; i < 16; ++i) {
            float c = rc[i], sn = rc[1024 + i];
            float a = v[i], bb = v[i + 16];
            v[i] = a * c - bb * sn;
            v[i + 16] = bb * c + a * sn;
          }
        }
        if (isq) {
#pragma unroll
          for (int i = 0; i < 32; ++i) v[i] *= QSCALE;
        }
      }
      store_bf16_32(p.P + (size_t)R * PW + col0, v);
    }
  }
}

#define DPPF(v, ctrl) __int_as_float(__builtin_amdgcn_update_dpp(0, __float_as_int(v), (ctrl), 0xf, 0xf, true))
DI float red8(float v) {
  v += DPPF(v, 0xB1);
  v += DPPF(v, 0x4E);
  v += DPPF(v, 0x141);
  return v;
}
DI float red16(float v) {
  v += DPPF(v, 0xB1);
  v += DPPF(v, 0x4E);
  v += DPPF(v, 0x141);
  v += DPPF(v, 0x140);
  return v;
}
DI void dot4x2_s(const float (&A)[4], const float (&B)[4], float n0, float n1, float n2, float n3, float& pa, float& pb) {
  asm("v_mul_f32 %0, %2, %10\n\t"
      "v_mul_f32 %1, %6, %10\n\t"
      "v_fma_f32 %0, %3, %11, %0\n\t"
      "v_fma_f32 %1, %7, %11, %1\n\t"
      "v_fma_f32 %0, %4, %12, %0\n\t"
      "v_fma_f32 %1, %8, %12, %1\n\t"
      "v_fma_f32 %0, %5, %13, %0\n\t"
      "v_fma_f32 %1, %9, %13, %1"
      : "=&v"(pa), "=&v"(pb)
      : "v"(A[0]), "v"(A[1]), "v"(A[2]), "v"(A[3]), "v"(B[0]), "v"(B[1]), "v"(B[2]), "v"(B[3]), "v"(n0), "v"(n1), "v"(n2), "v"(n3));
}
DI void upd4x2_s(float (&A)[4], float (&B)[4], float va, float vb, float saa, float sab,
                 float kd0, float kd1, float kd2, float kd3, float ka0, float ka1, float ka2, float ka3,
                 float w0, float w1, float w2, float w3) {
  float t0, t1;
  asm("v_mul_f32 %8, %10, %14\n\t"  "v_mul_f32 %9, %11, %14\n\t"
      "v_fma_f32 %8, %12, %18, %8\n\t"  "v_fma_f32 %9, %13, %18, %9\n\t"
      "v_fma_f32 %0, %0, %22, %8\n\t"  "v_fma_f32 %4, %4, %22, %9\n\t"
      "v_mul_f32 %8, %10, %15\n\t"  "v_mul_f32 %9, %11, %15\n\t"
      "v_fma_f32 %8, %12, %19, %8\n\t"  "v_fma_f32 %9, %13, %19, %9\n\t"
      "v_fma_f32 %1, %1, %23, %8\n\t"  "v_fma_f32 %5, %5, %23, %9\n\t"
      "v_mul_f32 %8, %10, %16\n\t"  "v_mul_f32 %9, %11, %16\n\t"
      "v_fma_f32 %8, %12, %20, %8\n\t"  "v_fma_f32 %9, %13, %20, %9\n\t"
      "v_fma_f32 %2, %2, %24, %8\n\t"  "v_fma_f32 %6, %6, %24, %9\n\t"
      "v_mul_f32 %8, %10, %17\n\t"  "v_mul_f32 %9, %11, %17\n\t"
      "v_fma_f32 %8, %12, %21, %8\n\t"  "v_fma_f32 %9, %13, %21, %9\n\t"
      "v_fma_f32 %3, %3, %25, %8\n\t"  "v_fma_f32 %7, %7, %25, %9"
      : "+v"(A[0]), "+v"(A[1]), "+v"(A[2]), "+v"(A[3]), "+v"(B[0]), "+v"(B[1]), "+v"(B[2]), "+v"(B[3]), "=&v"(t0), "=&v"(t1)
      : "v"(va), "v"(vb), "v"(saa), "v"(sab), "v"(kd0), "v"(kd1), "v"(kd2), "v"(kd3), "v"(ka0), "v"(ka1), "v"(ka2), "v"(ka3),
        "v"(w0), "v"(w1), "v"(w2), "v"(w3));
}
constexpr int RC = 32;
DI void rwkv_job(const Params& p, int l, int job, char* smem) {
  const int half = job & 1, jb = job >> 1;
  const int d = jb >> 6, b = (jb >> 3) & 7, h = jb & 7;
  const int tid = ltid(), wave = tid >> 6, lane = tid & 63, r = lane & 31, hh = lane >> 5;
  float* op = (float*)smem;
  char* atw = smem + 49152;
  char* ata = smem + 49152 + 4608;
  float* cst = (float*)(smem + 49152 + 9216);
  const u16* Pb = p.P + (size_t)b * TPB * PW;
  const int pt = tid >> 3, ps = tid & 7;
  __syncthreads();
  if (tid < 64) {
    const float* mu = p.rwkv_mu + l * 1792;
    const int hc = h * 64 + tid;
    cst[tid] = mu[PC_R + hc]; cst[64 + tid] = mu[PC_K + hc]; cst[128 + tid] = mu[PC_V + hc];
    cst[192 + tid] = mu[PC_WD + tid]; cst[256 + tid] = mu[PC_AD + tid];
    cst[320 + tid] = p.rwkv_k_k[l * 512 + hc]; cst[384 + tid] = p.rwkv_k_a[l * 512 + hc]; cst[448 + tid] = p.rwkv_r_k[l * 512 + hc];
  }
  const int mm = wave >> 1, nt = wave & 1;
  bf16x8 bw[4];
  float bias;
  {
    const float* W = (mm == 0 ? p.rwkv_w_up : p.rwkv_a_up) + ((size_t)(l * 2 + d) * 64) * 512 + h * 64 + nt * 32 + r;
#pragma unroll
    for (int ks = 0; ks < 4; ++ks)
#pragma unroll
      for (int jj = 0; jj < 8; ++jj) bw[ks][jj] = (short)f2bf(W[(size_t)(16 * ks + 8 * hh + jj) * 512]);
    bias = (mm == 0 ? p.rwkv_w0 : p.rwkv_a0)[(l * 2 + d) * 512 + h * 64 + nt * 32 + r];
  }
  const int rp = lane >> 4, kg = lane & 15;
  float SA[4], SB[4];
#pragma unroll
  for (int i = 0; i < 4; ++i) { SA[i] = 0.f; SB[i] = 0.f; }
  const int myrow = 32 * half + 8 * wave + 2 * rp;
  u16* ysb = p.R2 + (size_t)d * NTOK * 512 + (size_t)b * TPB * 512 + h * 64 + myrow;

  u32x4 q_rp, q_rm, q_rn, q_kp, q_km, q_kn, q_vp, q_vm, q_vn, q_wp, q_wm, q_wn, q_ap, q_am, q_an;
  bool hp, hn;
  int ptok;
#define RW_TOK(s_, tok_, pos_, len_)                                                        \
  {                                                                                         \
    if ((s_) < CTXL) { pos_ = d ? (CTXL - 1 - (s_)) : (s_); len_ = CTXL; tok_ = pos_; }     \
    else { pos_ = d ? (SEQ - 1 - ((s_) - CTXL)) : ((s_) - CTXL); len_ = SEQ; tok_ = CTXL + pos_; } \
  }
#define RW_LD3(P_, M_, N_, col_)                                                            \
  {                                                                                         \
    const u16* a_ = prow + (col_);                                                          \
    M_ = *(const u32x4*)a_;                                                                 \
    P_ = hp ? *(const u32x4*)(a_ - PW) : (u32x4){0, 0, 0, 0};                               \
    N_ = hn ? *(const u32x4*)(a_ + PW) : (u32x4){0, 0, 0, 0};                               \
  }
#define RW_PREFETCH(c_)                                                                     \
  {                                                                                         \
    int pos_, len_;                                                                         \
    const int s_ = (c_) * RC + pt;                                                          \
    RW_TOK(s_, ptok, pos_, len_);                                                           \
    hp = pos_ > 0; hn = pos_ < len_ - 1;                                                    \
    const u16* prow = Pb + (size_t)ptok * PW;                                               \
    RW_LD3(q_rp, q_rm, q_rn, PC_R + h * 64 + ps * 8)                                        \
    RW_LD3(q_kp, q_km, q_kn, PC_K + h * 64 + ps * 8)                                        \
    RW_LD3(q_vp, q_vm, q_vn, PC_V + h * 64 + ps * 8)                                        \
    RW_LD3(q_wp, q_wm, q_wn, PC_WD + ps * 8)                                                \
    RW_LD3(q_ap, q_am, q_an, PC_AD + ps * 8)                                                \
  }
#define RW_LERP(P_, M_, N_, muoff_, o_)                                                     \
  {                                                                                         \
    float x_[8], xp_[8], xn_[8];                                                            \
    unpack8(__builtin_bit_cast(uint4, M_), x_); unpack8(__builtin_bit_cast(uint4, P_), xp_); unpack8(__builtin_bit_cast(uint4, N_), xn_); \
    const float4 m0_ = *(const float4*)(cst + (muoff_) + ps * 8), m1_ = *(const float4*)(cst + (muoff_) + ps * 8 + 4); \
    const float m_[8] = {m0_.x, m0_.y, m0_.z, m0_.w, m1_.x, m1_.y, m1_.z, m1_.w};           \
    _Pragma("unroll") for (int i_ = 0; i_ < 8; ++i_) o_[i_] = x_[i_] + m_[i_] * (0.5f * (xp_[i_] + xn_[i_]) - x_[i_]); \
  }
  RW_PREFETCH(0);
  __syncthreads();
#pragma unroll 1
  for (int c = 0; c < TPB / RC; ++c) {
    const int ctok = ptok;
    {
      float o[8];
      float* ob = op + pt * 384 + ps * 8;
      RW_LERP(q_rp, q_rm, q_rn, 0, o)
      *(float4*)(ob) = make_float4(o[0], o[1], o[2], o[3]); *(float4*)(ob + 4) = make_float4(o[4], o[5], o[6], o[7]);
      RW_LERP(q_kp, q_km, q_kn, 64, o)
      *(float4*)(ob + 128) = make_float4(o[0], o[1], o[2], o[3]); *(float4*)(ob + 132) = make_float4(o[4], o[5], o[6], o[7]);
      RW_LERP(q_vp, q_vm, q_vn, 128, o)
      *(float4*)(ob + 320) = make_float4(o[0], o[1], o[2], o[3]); *(float4*)(ob + 324) = make_float4(o[4], o[5], o[6], o[7]);
      RW_LERP(q_wp, q_wm, q_wn, 192, o)
      uint4 t4;
      t4.x = pack2(tanh_fast(o[0]), tanh_fast(o[1])); t4.y = pack2(tanh_fast(o[2]), tanh_fast(o[3])); t4.z = pack2(tanh_fast(o[4]), tanh_fast(o[5])); t4.w = pack2(tanh_fast(o[6]), tanh_fast(o[7]));
      *(uint4*)(atw + pt * 144 + ps * 16) = t4;
      RW_LERP(q_ap, q_am, q_an, 256, o)
      t4.x = pack2(o[0], o[1]); t4.y = pack2(o[2], o[3]); t4.z = pack2(o[4], o[5]); t4.w = pack2(o[6], o[7]);
      *(uint4*)(ata + pt * 144 + ps * 16) = t4;
    }
    __syncthreads();
    {
      f32x16 z;
#pragma unroll
      for (int i = 0; i < 16; ++i) z[i] = bias;
      const char* at = (mm == 0 ? atw : ata) + r * 144 + hh * 16;
#pragma unroll
      for (int ks = 0; ks < 4; ++ks) z = MFMA32(*(const bf16x8*)(at + ks * 32), bw[ks], z);
      float* ob = op + (mm == 0 ? 64 : 256) + nt * 32 + r;
#pragma unroll
      for (int i = 0; i < 16; ++i) ob[crow(i, hh) * 384] = z[i];
    }
    __syncthreads();
    {
      float* ob = op + pt * 384 + ps * 8;
      float rr[8], kx[8], wp[8], ap[8], kkc[8], kac[8], rkc[8];
#define RW_RD8(dst_, ptr_) { const float4 u0_ = *(const float4*)(ptr_), u1_ = *(const float4*)((ptr_) + 4); dst_[0] = u0_.x; dst_[1] = u0_.y; dst_[2] = u0_.z; dst_[3] = u0_.w; dst_[4] = u1_.x; dst_[5] = u1_.y; dst_[6] = u1_.z; dst_[7] = u1_.w; }
      RW_RD8(rr, ob) RW_RD8(wp, ob + 64) RW_RD8(kx, ob + 128) RW_RD8(ap, ob + 256)
      RW_RD8(kkc, cst + 320 + ps * 8) RW_RD8(kac, cst + 384 + ps * 8) RW_RD8(rkc, cst + 448 + ps * 8)
      float dec[8], kk[8], kd[8], kka[8];
      float ss = 0.f, bon = 0.f;
#pragma unroll
      for (int i = 0; i < 8; ++i) {
        dec[i] = __expf(-0.6065306597126334f * sigm(wp[i]));
        const float a = sigm(ap[i]);
        kk[i] = kx[i] * kkc[i];
        ss += kk[i] * kk[i];
        kd[i] = kx[i] * (1.f + (a - 1.f) * kac[i]);
        bon += rr[i] * kd[i] * rkc[i];
        kka[i] = a;
      }
      ss = red8(ss); bon = red8(bon);
      const float rn = rsqrtf(fmaxf(ss, 1e-24f));
#pragma unroll
      for (int i = 0; i < 8; ++i) { kk[i] *= rn; kka[i] *= kk[i]; }
      *(float4*)(ob + 64) = make_float4(dec[0], dec[1], dec[2], dec[3]); *(float4*)(ob + 68) = make_float4(dec[4], dec[5], dec[6], dec[7]);
      *(float4*)(ob + 128) = make_float4(kd[0], kd[1], kd[2], kd[3]); *(float4*)(ob + 132) = make_float4(kd[4], kd[5], kd[6], kd[7]);
      *(float4*)(ob + 192) = make_float4(-kk[0], -kk[1], -kk[2], -kk[3]); *(float4*)(ob + 196) = make_float4(-kk[4], -kk[5], -kk[6], -kk[7]);
      *(float4*)(ob + 256) = make_float4(kka[0], kka[1], kka[2], kka[3]); *(float4*)(ob + 260) = make_float4(kka[4], kka[5], kka[6], kka[7]);
      if (ps == 0 && half == 0) p.bonus[((size_t)d * NTOK + (size_t)b * TPB + ctok) * 8 + h] = bon;
    }
    if (c + 1 < TPB / RC) RW_PREFETCH(c + 1);
    __syncthreads();
#define RW_LDOPS(X, st_)                                                                     \
    {                                                                                          \
      const float* ob_ = op + (st_) * 384 + kg * 4;                                            \
      X##r0 = *(const float4*)(ob_);                                                           \
      X##w0 = *(const float4*)(ob_ + 64);                                                      \
      X##d0 = *(const float4*)(ob_ + 128);                                                     \
      X##n0 = *(const float4*)(ob_ + 192);                                                     \
      X##a0 = *(const float4*)(ob_ + 256);                                                     \
      X##vv = *(const float2*)(op + (st_) * 384 + 320 + myrow);                                \
    }
#define RW_STEP(X, st_)                                                                        \
    {                                                                                          \
      float pa_, pb_;                                                                          \
      dot4x2_s(SA, SB, X##n0.x, X##n0.y, X##n0.z, X##n0.w, pa_, pb_);                          \
      const float saa_ = red16(pa_), sab_ = red16(pb_);                                        \
      upd4x2_s(SA, SB, X##vv.x, X##vv.y, saa_, sab_, X##d0.x, X##d0.y, X##d0.z, X##d0.w,       \
               X##a0.x, X##a0.y, X##a0.z, X##a0.w, X##w0.x, X##w0.y, X##w0.z, X##w0.w);        \
      float ya_, yb_;                                                                          \
      dot4x2_s(SA, SB, X##r0.x, X##r0.y, X##r0.z, X##r0.w, ya_, yb_);                          \
      const float yy0_ = red16(ya_), yy1_ = red16(yb_);                                        \
      const bool mine_ = kg == ((st_) & 15);          \
      ykeep0 = mine_ ? yy0_ : ykeep0; ykeep1 = mine_ ? yy1_ : ykeep1;                          \
      if (((st_) & 15) == 15) {                       \
        const int s_ = c * RC + (st_) - 15 + kg;                                               \
        int tok_, pos_, len_;                                                                  \
        RW_TOK(s_, tok_, pos_, len_);                                                          \
        (void)pos_; (void)len_;                                                                \
        *(unsigned*)(ysb + (size_t)tok_ * 512) = pack2(ykeep0, ykeep1);                        \
      }                                                                                        \
    }
    {
      float4 Ar0, Aw0, Ad0, An0, Aa0, Br0, Bw0, Bd0, Bn0, Ba0;
      float2 Avv, Bvv;
      float ykeep0 = 0.f, ykeep1 = 0.f;
      RW_LDOPS(A, 0)
#pragma unroll 1
      for (int st = 0; st < RC; st += 2) {
        RW_LDOPS(B, st + 1)
        RW_STEP(A, st)
        const int sn = st + 2 < RC ? st + 2 : RC - 1;
        RW_LDOPS(A, sn)
        RW_STEP(B, st + 1)
      }
    }
#undef RW_LDOPS
#undef RW_STEP
    __syncthreads();
  }
#undef RW_TOK
#undef RW_LD3
#undef RW_PREFETCH
#undef RW_LERP
#undef RW_RD8
}

#define WAVE_LDS_SYNC() do { __builtin_amdgcn_fence(__ATOMIC_RELEASE, "wavefront"); __builtin_amdgcn_wave_barrier(); __builtin_amdgcn_fence(__ATOMIC_ACQUIRE, "wavefront"); } while (0)
DI void s5_job(const Params& p, int l, int job, char* smem) {
  const int b = job >> 3, gi = job & 7;
  const int tid = ltid(), wave = tid >> 6, lane = tid & 63;
  const int g = gi * 4 + wave;
  const int col = lane & 15, quad = lane >> 4;
  float* Bu = (float*)(smem + wave * 12800);
  u16* Xs = (u16*)(smem + wave * 12800 + 8192);
  u16* Pb = p.P + (size_t)b * TPB * PW + PC_U + g * 16;
  u16* Sb = p.S5S + (size_t)b * TPB * 512 + g * 16;
  bf16x8 cf[4];
#pragma unroll
  for (int ks = 0; ks < 4; ++ks)
#pragma unroll
    for (int j = 0; j < 8; ++j) {
      int k = 32 * ks + 8 * quad + j, n = k >> 1;
      size_t idx = ((size_t)(l * 32 + g) * 16 + col) * 64 + n;
      float v = (k & 1) == 0 ? p.ssm_c_re[idx] : -p.ssm_c_im[idx];
      cf[ks][j] = (short)f2bf(v);
    }
  const float dsk = p.ssm_d[l * 512 + g * 16 + col];
#pragma unroll 1
  for (int pass = 0; pass < 2; ++pass) {
    const int d = 1 - pass;
    const float dt = __expf(p.ssm_log_dt[(l * 2 + d) * 32 + g]);
    float abr, abi;
    {
      size_t ia = ((size_t)(l * 2 + d) * 32 + g) * 64 + lane;
      float lr = fminf(p.ssm_a_re[ia], -1e-4f), li = p.ssm_a_im[ia];
      float mag = expf(lr * dt);
      abr = mag * cosf(li * dt); abi = mag * sinf(li * dt);
    }
    bf16x8 bfr[8];
#pragma unroll
    for (int q4 = 0; q4 < 4; ++q4) {
      const int n = 16 * q4 + col;
      size_t ia = ((size_t)(l * 2 + d) * 32 + g) * 64 + n;
      float lr = fminf(p.ssm_a_re[ia], -1e-4f), li = p.ssm_a_im[ia];
      float mag = expf(lr * dt);
      float ar = mag * cosf(li * dt), ai = mag * sinf(li * dt);
      float nr = ar - 1.f, ni = ai;
      float den = lr * lr + li * li;
      float cr = (nr * lr + ni * li) / den, ci = (ni * lr - nr * li) / den;
#pragma unroll
      for (int j = 0; j < 8; ++j) {
        float vr = 0.f, vi = 0.f;
        if (quad < 2) {
          size_t ib = ((size_t)(l * 32 + g) * 64 + n) * 16 + 8 * quad + j;
          float br = p.ssm_b_re[ib], bi = p.ssm_b_im[ib];
          vr = cr * br - ci * bi; vi = cr * bi + ci * br;
        }
        bfr[q4][j] = (short)f2bf(vr);
        bfr[4 + q4][j] = (short)f2bf(vi);
      }
    }
    float xr = 0.f, xi = 0.f;
    bf16x8 ua_next = {0, 0, 0, 0, 0, 0, 0, 0};
    if (quad < 2) ua_next = *(const bf16x8*)(Pb + (size_t)((d == 0 ? 0 : CTXL - 16) + col) * PW + 8 * quad);
#pragma unroll 1
    for (int c = 0; c < TPB / 16; ++c) {
      int tlo;
      if (d == 0) tlo = 16 * c;
      else tlo = c < 16 ? (CTXL - 16 - 16 * c) : (CTXL + SEQ - 16 - 16 * (c - 16));
      bf16x8 ua = ua_next;
      {
        const int cn = c + 1 < TPB / 16 ? c + 1 : c;
        int tln;
        if (d == 0) tln = 16 * cn;
        else tln = cn < 16 ? (CTXL - 16 - 16 * cn) : (CTXL + SEQ - 16 - 16 * (cn - 16));
        if (quad < 2) ua_next = *(const bf16x8*)(Pb + (size_t)(tln + col) * PW + 8 * quad);
      }
      u16 pu[4] = {0, 0, 0, 0}, psb[4] = {0, 0, 0, 0};
      if (pass == 1) {
#pragma unroll
        for (int q = 0; q < 4; ++q) { pu[q] = Pb[(size_t)(tlo + quad * 4 + q) * PW + col]; psb[q] = Sb[(size_t)(tlo + quad * 4 + q) * 512 + col]; }
      }
#pragma unroll
      for (int nt = 0; nt < 8; ++nt) {
        f32x4 z = {0.f, 0.f, 0.f, 0.f};
        z = MFMA16(ua, bfr[nt], z);
#pragma unroll
        for (int q = 0; q < 4; ++q) Bu[(quad * 4 + q) * 128 + nt * 16 + col] = z[q];
      }
      WAVE_LDS_SYNC();
#pragma unroll
      for (int tt = 0; tt < 16; ++tt) {
        const int t = d ? 15 - tt : tt;
        float br = Bu[t * 128 + lane], bi = Bu[t * 128 + 64 + lane];
        float nr = abr * xr - abi * xi + br;
        float ni = abr * xi + abi * xr + bi;
        xr = nr; xi = ni;
        *(unsigned*)(Xs + t * 136 + 2 * lane) = pack2(xr, xi);
      }
      WAVE_LDS_SYNC();
      f32x4 y = {0.f, 0.f, 0.f, 0.f};
#pragma unroll
      for (int ks = 0; ks < 4; ++ks) {
        bf16x8 a = *(const bf16x8*)(Xs + col * 136 + 32 * ks + 8 * quad);
        y = MFMA16(a, cf[ks], y);
      }
#pragma unroll
      for (int q = 0; q < 4; ++q) {
        const int tok = tlo + quad * 4 + q;
        if (pass == 0) {
          Sb[(size_t)tok * 512 + col] = f2bf(y[q]);
        } else {
          float u = bf2f(pu[q]);
          float v = y[q] + bf2f(psb[q]) + dsk * u;
          float gl = 0.5f * v * (1.f + tanh_fast(0.7978845608028654f * (v + 0.044715f * v * v * v)));
          Pb[(size_t)tok * PW + col] = f2bf(gl);
        }
      }
      WAVE_LDS_SYNC();
    }
  }
}

DI void attn_job(const Params& p, int l, int bk, int qt, char* smem) {
  const int kvh = bk & 3, b = bk >> 2;
  const int tid = ltid(), wave = tid >> 6, lane = tid & 63, r = lane & 31, h = lane >> 5;
  const int nt = (qt < 4 ? CTXL : TPB) / 64;
  const int head = kvh * 4 + wave;
  const size_t R0 = (size_t)b * TPB + qt * 64;
  u16* Ks = (u16*)smem;
  u16* Vs = (u16*)(smem + 18432);
  bf16x8 qf[2][4];
#pragma unroll
  for (int qs = 0; qs < 2; ++qs) {
    const u16* qp = p.P + (R0 + qs * 32 + r) * PW + PC_Q + head * 64 + 8 * h;
#pragma unroll
    for (int ks = 0; ks < 4; ++ks) qf[qs][ks] = *(const bf16x8*)(qp + 16 * ks);
  }
  f32x16 ot[2][2];
#pragma unroll
  for (int i = 0; i < 16; ++i) { ot[0][0][i] = 0.f; ot[0][1][i] = 0.f; ot[1][0][i] = 0.f; ot[1][1][i] = 0.f; }
  float lp0 = 0.f, lp1 = 0.f;
  float soff;
  {
    float gq = fabsf(p.attn_q_gain[l * 64 + lane]), gk = fabsf(p.attn_k_gain[l * 64 + lane]);
#pragma unroll
    for (int o = 32; o > 0; o >>= 1) { gq = fmaxf(gq, __shfl_xor(gq, o)); gk = fmaxf(gk, __shfl_xor(gk, o)); }
    soff = 8.f * 1.4426950408889634f * gq * gk * 1.02f + 0.5f;
  }
  f32x16 negoff;
#pragma unroll
  for (int i = 0; i < 16; ++i) negoff[i] = -soff;
  const int lrow = tid >> 2, lseg = (tid & 3) * 16;
  const u16* kg = p.P + ((size_t)b * TPB + lrow) * PW + PC_KK + kvh * 64 + lseg;
  const u16* vg = p.Vt + ((size_t)(b * 4 + kvh) * 64 + lrow) * TPB + lseg;
  uint4 kr0, kr1, vr0, vr1;
#define ATT_GLOAD(t_) { const uint4* ks_ = (const uint4*)(kg + (size_t)(t_) * 64 * PW); const uint4* vs_ = (const uint4*)(vg + (t_) * 64); kr0 = ks_[0]; kr1 = ks_[1]; vr0 = vs_[0]; vr1 = vs_[1]; }
#define ATT_LSTORE(b_) { uint4* kd_ = (uint4*)(Ks + (b_) * 4608 + lrow * 72 + lseg); uint4* vd_ = (uint4*)(Vs + (b_) * 4608 + lrow * 72 + lseg); kd_[0] = kr0; kd_[1] = kr1; vd_[0] = vr0; vd_[1] = vr1; }
  __syncthreads();
  ATT_GLOAD(0); ATT_LSTORE(0);
  __syncthreads();
#pragma unroll 1
  for (int t = 0; t < nt; ++t) {
    const int bufi = t & 1;
    if (t + 1 < nt) ATT_GLOAD(t + 1);
    const u16* Kb = Ks + bufi * 4608;
    const u16* Vb = Vs + bufi * 4608;
    f32x16 st[2][2];
    __builtin_amdgcn_s_setprio(1);
#pragma unroll
    for (int k2 = 0; k2 < 2; ++k2) {
#pragma unroll
      for (int ks = 0; ks < 4; ++ks) {
        bf16x8 a = *(const bf16x8*)(Kb + (k2 * 32 + r) * 72 + ks * 16 + h * 8);
        st[0][k2] = (ks == 0) ? MFMA32(a, qf[0][ks], negoff) : MFMA32(a, qf[0][ks], st[0][k2]);
        st[1][k2] = (ks == 0) ? MFMA32(a, qf[1][ks], negoff) : MFMA32(a, qf[1][ks], st[1][k2]);
      }
    }
    __builtin_amdgcn_s_setprio(0);
    float ps0 = 0.f, ps1 = 0.f;
#pragma unroll
    for (int i = 0; i < 16; ++i) {
      st[0][0][i] = __builtin_amdgcn_exp2f(st[0][0][i]); st[0][1][i] = __builtin_amdgcn_exp2f(st[0][1][i]);
      st[1][0][i] = __builtin_amdgcn_exp2f(st[1][0][i]); st[1][1][i] = __builtin_amdgcn_exp2f(st[1][1][i]);
      ps0 += st[0][0][i] + st[0][1][i]; ps1 += st[1][0][i] + st[1][1][i];
    }
    lp0 += ps0; lp1 += ps1;
#pragma unroll
    for (int k2 = 0; k2 < 2; ++k2)
#pragma unroll
      for (int s = 0; s < 2; ++s) {
        uint4 pk0, pk1;
        pk0.x = pack2(st[0][k2][8 * s], st[0][k2][8 * s + 1]); pk0.y = pack2(st[0][k2][8 * s + 2], st[0][k2][8 * s + 3]);
        pk0.z = pack2(st[0][k2][8 * s + 4], st[0][k2][8 * s + 5]); pk0.w = pack2(st[0][k2][8 * s + 6], st[0][k2][8 * s + 7]);
        pk1.x = pack2(st[1][k2][8 * s], st[1][k2][8 * s + 1]); pk1.y = pack2(st[1][k2][8 * s + 2], st[1][k2][8 * s + 3]);
        pk1.z = pack2(st[1][k2][8 * s + 4], st[1][k2][8 * s + 5]); pk1.w = pack2(st[1][k2][8 * s + 6], st[1][k2][8 * s + 7]);
        const bf16x8 pb0 = __builtin_bit_cast(bf16x8, pk0), pb1 = __builtin_bit_cast(bf16x8, pk1);
#pragma unroll
        for (int dt = 0; dt < 2; ++dt) {
          const u16* vp = Vb + (dt * 32 + r) * 72 + k2 * 32 + 16 * s + 4 * h;
          bf16x4 lo = *(const bf16x4*)vp;
          bf16x4 hi = *(const bf16x4*)(vp + 8);
          bf16x8 a = __builtin_shufflevector(lo, hi, 0, 1, 2, 3, 4, 5, 6, 7);
          ot[0][dt] = MFMA32(a, pb0, ot[0][dt]);
          ot[1][dt] = MFMA32(a, pb1, ot[1][dt]);
        }
      }
    if (t + 1 < nt) ATT_LSTORE(bufi ^ 1);
    __syncthreads();
  }
#pragma unroll
  for (int qs = 0; qs < 2; ++qs) {
    const float lpart = qs == 0 ? lp0 : lp1;
    const float lsum = lpart + __shfl_xor(lpart, 32);
    const float inv = 1.f / lsum;
    u16* op = p.P + (R0 + qs * 32 + r) * PW + PC_Q + head * 64;
#pragma unroll
    for (int dt = 0; dt < 2; ++dt)
#pragma unroll
      for (int i4 = 0; i4 < 4; ++i4) {
        uint2 o;
        o.x = pack2(ot[qs][dt][4 * i4] * inv, ot[qs][dt][4 * i4 + 1] * inv);
        o.y = pack2(ot[qs][dt][4 * i4 + 2] * inv, ot[qs][dt][4 * i4 + 3] * inv);
        *(uint2*)(op + dt * 32 + 8 * i4 + 4 * h) = o;
      }
  }
}

constexpr int NJ_RWKV = 256, NJ_S5 = 64, NJ_ATT = NB * 4 * 136;
DI int fetch_job(int* ctr, int* s_job) {
  __syncthreads();
  if (ltid() == 0) *s_job = atomicAdd(ctr, 1);
  __syncthreads();
  return *s_job;
}
DI void phaseB(const Params& p, int l, char* smem) {
  __shared__ int s_job;
  __syncthreads();
  if (ltid() == 0) {
    const unsigned hw = (unsigned)__builtin_amdgcn_s_getreg((7 << 11) | (8 << 6) | 4);
    const unsigned xcc = (unsigned)__builtin_amdgcn_s_getreg((3 << 11) | 20) & 0xFu;
    const unsigned key = (xcc << 8) | (hw & 0xffu);
    s_job = atomicAdd(p.cuc + l * 4096 + (int)key, 1);
  }
  __syncthreads();
  const int slot = s_job;
  if (slot == 0) {
    const int job = fetch_job(p.ctr + l, &s_job);
    if (job < NJ_RWKV) { __builtin_amdgcn_s_setprio(3); rwkv_job(p, l, job, smem); __builtin_amdgcn_s_setprio(0); }
  } else {
    const int job = fetch_job(p.ctr + 4 + l, &s_job);
    if (job < NJ_S5) { __builtin_amdgcn_s_setprio(2); s5_job(p, l, job, smem); __builtin_amdgcn_s_setprio(0); }
  }
  const int x = blockIdx.x & 7;
#pragma unroll 1
  for (int k = 0; k < 8; ++k) {
    const int xq = (x + k) & 7;
    for (;;) {
      const int n = fetch_job(p.ctr + 8 + l * 8 + xq, &s_job);
      if (n >= 4 * 68) break;
      attn_job(p, l, xq * 4 + n / 68, 67 - (n % 68), smem);
    }
  }
  for (;;) {
    const int job = fetch_job(p.ctr + l, &s_job);
    if (job >= NJ_RWKV) break;
    rwkv_job(p, l, job, smem);
  }
  for (;;) {
    const int job = fetch_job(p.ctr + 4 + l, &s_job);
    if (job >= NJ_S5) break;
    s5_job(p, l, job, smem);
  }
}

DI void phaseC0_tile(const Params& p, int l, int t, char* smem) {
  const int tid = ltid();
  const bool glu = t >= NROWT * 4;
  if (glu) t -= NROWT * 4;
  const int rt = t >> 2, ct = t & 3, m0 = rt * 128, n0 = ct * 128;
  f32x16 acc[2][2];
  zero_acc(acc);
  ASrc as{};
  as.m0 = m0;
  if (!glu) {
    as.A16 = p.P + (size_t)m0 * PW; as.mu = p.rwkv_mu + l * 1792;
    gemm_main<AK_GD>(acc, as, p.WB + W_GUP + (size_t)n0 * 128, 128, 128, smem);
  } else {
    as.A16 = p.P + (size_t)m0 * PW + PC_U; as.lda = PW;
    gemm_main<AK_BF16>(acc, as, p.WB + W_GLU + (size_t)n0 * 512, 512, 512, smem);
  }
#pragma unroll 1
  for (int hf = 0; hf < 2; ++hf) {
    stage_half(acc, hf, smem);
    const int R = m0 + hf * 64 + (tid >> 2);
    const int col0 = n0 + (tid & 3) * 32;
    const u16* prow = p.P + (size_t)R * PW;
    const float* srow = (const float*)smem + (tid >> 2) * 132 + (tid & 3) * 32;
    if (!glu) {
      const int hd = col0 >> 6;
      const u16* y0 = p.R2 + (size_t)R * 512 + col0;
      const u16* y1 = y0 + (size_t)NTOK * 512;
      float s0 = 0.f, s1 = 0.f;
#pragma unroll 1
      for (int c8 = 0; c8 < 4; ++c8) {
        float a[8], bq[8];
        unpack8(*(const uint4*)(y0 + 8 * c8), a);
        unpack8(*(const uint4*)(y1 + 8 * c8), bq);
#pragma unroll
        for (int i = 0; i < 8; ++i) { float y = a[i] + bq[i]; s0 += y; s1 += y * y; }
      }
      s0 += __shfl_xor(s0, 1); s1 += __shfl_xor(s1, 1);
      const float mean = s0 * (1.f / 64.f);
      const float var = fmaxf(s1 * (1.f / 64.f) - mean * mean, 0.f);
      const float rstd = rsqrtf(var + 64e-5f);
      const float bon = p.bonus[(size_t)R * 8 + hd] + p.bonus[((size_t)NTOK + R) * 8 + hd];
      const int s = R % TPB;
      const int pos = s < CTXL ? s : s - CTXL, len = s < CTXL ? CTXL : SEQ;
      const bool hp = pos > 0, hn = pos < len - 1;
      const float* mu = p.rwkv_mu + l * 1792;
      const float* gw = p.rwkv_gn_w + l * 512 + col0;
      const float* gb = p.rwkv_gn_b + l * 512 + col0;
#pragma unroll 1
      for (int c8 = 0; c8 < 4; ++c8) {
        float a[8], bq[8], vx[8], o[8];
        unpack8(*(const uint4*)(y0 + 8 * c8), a);
        unpack8(*(const uint4*)(y1 + 8 * c8), bq);
        lerp8(prow, PC_V + col0 + 8 * c8, hp, hn, mu, vx);
        float4 g0 = *(const float4*)(srow + 8 * c8), g1 = *(const float4*)(srow + 8 * c8 + 4);
        float gt[8] = {g0.x, g0.y, g0.z, g0.w, g1.x, g1.y, g1.z, g1.w};
#pragma unroll
        for (int i = 0; i < 8; ++i) {
          float yn = (a[i] + bq[i] - mean) * rstd * gw[8 * c8 + i] + gb[8 * c8 + i];
          o[i] = (yn + bon * vx[i]) * gt[i];
        }
        uint4 q;
        q.x = pack2(o[0], o[1]); q.y = pack2(o[2], o[3]); q.z = pack2(o[4], o[5]); q.w = pack2(o[6], o[7]);
        *(uint4*)(p.P + (size_t)R * PW + PC_R + col0 + 8 * c8) = q;
      }
    } else {
      const float* gb = p.ssm_glu_b + l * 512 + col0;
#pragma unroll 1
      for (int c8 = 0; c8 < 4; ++c8) {
        float yv[8], o[8];
        unpack8(*(const uint4*)(prow + PC_U + col0 + 8 * c8), yv);
        float4 g0 = *(const float4*)(srow + 8 * c8), g1 = *(const float4*)(srow + 8 * c8 + 4);
        float gt[8] = {g0.x, g0.y, g0.z, g0.w, g1.x, g1.y, g1.z, g1.w};
#pragma unroll
        for (int i = 0; i < 8; ++i) o[i] = yv[i] * sigm(gt[i] + gb[8 * c8 + i]);
        uint4 q;
        q.x = pack2(o[0], o[1]); q.y = pack2(o[2], o[3]); q.z = pack2(o[4], o[5]); q.w = pack2(o[6], o[7]);
        *(uint4*)(p.P + (size_t)R * PW + PC_K + col0 + 8 * c8) = q;
      }
    }
  }
}

DI void phaseC1_tile(const Params& p, int l, int t, char* smem) {
  const int tid = ltid();
  const int rt = t >> 3, ct = t & 7, m0 = rt * 128, n0 = ct * 128;
  const int mi = mod_index(rt);
  const float* mv = p.modv + ((size_t)l * 9 + mi) * 6144;
#pragma unroll 1
  for (int br = 0; br < 3; ++br) {
    {
      unsigned sg[2][2][8];
      f32x16 acc[2][2];
      zero_acc(acc);
      ASrc as{};
      as.A16 = p.XN + (size_t)m0 * 1024; as.lda = 1024; as.m0 = m0;
      gemm_main<AK_BF16>(acc, as, p.WB + W_IN + (size_t)(GATE_OFF + br * 1024 + n0) * 1024, 1024, 1024, smem);
#pragma unroll
      for (int a = 0; a < 2; ++a)
#pragma unroll
        for (int bq = 0; bq < 2; ++bq)
#pragma unroll
          for (int i = 0; i < 8; ++i) sg[a][bq][i] = pack2(sigm(acc[a][bq][2 * i]), sigm(acc[a][bq][2 * i + 1]));
      uint4* gs = (uint4*)p.S5S + (size_t)blockIdx.x * 8 * NTHREADS + tid;
#pragma unroll
      for (int a = 0; a < 2; ++a)
#pragma unroll
        for (int bq = 0; bq < 2; ++bq) {
          gs[((a * 2 + bq) * 2 + 0) * NTHREADS] = make_uint4(sg[a][bq][0], sg[a][bq][1], sg[a][bq][2], sg[a][bq][3]);
          gs[((a * 2 + bq) * 2 + 1) * NTHREADS] = make_uint4(sg[a][bq][4], sg[a][bq][5], sg[a][bq][6], sg[a][bq][7]);
        }
    }
    f32x16 acc[2][2];
    zero_acc(acc);
    ASrc as{};
    as.m0 = m0; as.lda = PW;
    const u16* Bp; int K;
    if (br == 0) { as.A16 = p.P + (size_t)m0 * PW + PC_R; Bp = p.WB + W_PA; K = 512; }
    else if (br == 1) { as.A16 = p.P + (size_t)m0 * PW + PC_Q; Bp = p.WB + W_PB; K = 1024; }
    else { as.A16 = p.P + (size_t)m0 * PW + PC_K; Bp = p.WB + W_PC; K = 512; }
    gemm_main<AK_BF16>(acc, as, Bp + (size_t)n0 * K, K, K, smem);
#pragma unroll
    for (int a = 0; a < 2; ++a)
#pragma unroll
      for (int bq = 0; bq < 2; ++bq)
      {
        const uint4* gs = (const uint4*)p.S5S + (size_t)blockIdx.x * 8 * NTHREADS + tid;
        const uint4 g0 = gs[((a * 2 + bq) * 2 + 0) * NTHREADS], g1 = gs[((a * 2 + bq) * 2 + 1) * NTHREADS];
        const unsigned gu[8] = {g0.x, g0.y, g0.z, g0.w, g1.x, g1.y, g1.z, g1.w};
#pragma unroll
        for (int i = 0; i < 8; ++i) {
          acc[a][bq][2 * i] *= __uint_as_float(gu[i] << 16);
          acc[a][bq][2 * i + 1] *= __uint_as_float(gu[i] & 0xffff0000u);
        }
      }
#pragma unroll 1
    for (int hf = 0; hf < 2; ++hf) {
      stage_half(acc, hf, smem);
      const int R = m0 + hf * 64 + (tid >> 2);
      u16* dst = p.R2 + (size_t)R * 1024 + n0 + (tid & 3) * 32;
      const float* srow = (const float*)smem + (tid >> 2) * 132 + (tid & 3) * 32;
#pragma unroll 1
      for (int c8 = 0; c8 < 4; ++c8) {
        float4 g0 = *(const float4*)(srow + 8 * c8), g1 = *(const float4*)(srow + 8 * c8 + 4);
        float o[8] = {g0.x, g0.y, g0.z, g0.w, g1.x, g1.y, g1.z, g1.w};
        if (br > 0) {
          float prev[8];
          unpack8(*(const uint4*)(dst + 8 * c8), prev);
#pragma unroll
          for (int i = 0; i < 8; ++i) o[i] += prev[i];
        }
        uint4 q;
        q.x = pack2(o[0], o[1]); q.y = pack2(o[2], o[3]); q.z = pack2(o[4], o[5]); q.w = pack2(o[6], o[7]);
        *(uint4*)(dst + 8 * c8) = q;
      }
    }
    __syncthreads();
  }
}

DI void residual_epilogue(const Params& p, const f32x16 (&acc)[2][2], int m0, int n0, int ct, const float* stats_in, const float* g_in, const float* b_in,
                          const float* gate, float* stats_out, char* smem) {
  const int tid = ltid();
#pragma unroll 1
  for (int hf = 0; hf < 2; ++hf) {
    stage_half(acc, hf, smem);
    float v[32];
    read_staged(v, smem);
    const int R = m0 + hf * 64 + (tid >> 2);
    const int col0 = n0 + (tid & 3) * 32;
    float mean = 0.f, rstd = 1.f;
    if (stats_in) row_stats(stats_in, R, mean, rstd);
    float4* xp = (float4*)(p.X + (size_t)R * 1024 + col0);
    const float4* xsrc = stats_in ? (const float4*)xp : (const float4*)(in_row(p, R) + col0);
    float s0 = 0.f, s1 = 0.f;
#pragma unroll
    for (int i = 0; i < 8; ++i) {
      float4 xv = xsrc[i];
      float xin[4] = {xv.x, xv.y, xv.z, xv.w};
      float o[4];
#pragma unroll
      for (int j = 0; j < 4; ++j) {
        int cc = col0 + 4 * i + j;
        float xi = xin[j];
        if (stats_in) xi = (xi - mean) * rstd * g_in[cc] + b_in[cc];
        float val = ALPHA * xi + gate[cc] * v[4 * i + j];
        o[j] = val; s0 += val; s1 += val * val;
      }
      xp[i] = make_float4(o[0], o[1], o[2], o[3]);
    }
    s0 += __shfl_xor(s0, 1); s1 += __shfl_xor(s1, 1);
    s0 += __shfl_xor(s0, 2); s1 += __shfl_xor(s1, 2);
    if ((tid & 3) == 0) { stats_out[(size_t)R * 16 + ct * 2] = s0; stats_out[(size_t)R * 16 + ct * 2 + 1] = s1; }
  }
}

DI void phaseC2_tile(const Params& p, int l, int t, char* smem) {
  const int rt = t >> 3, ct = t & 7, m0 = rt * 128, n0 = ct * 128;
  const int mi = mod_index(rt);
  const float* mv = p.modv + ((size_t)l * 9 + mi) * 6144;
  f32x16 acc[2][2];
  zero_acc(acc);
  ASrc as{};
  as.m0 = m0; as.lda = 1024; as.A16 = p.R2 + (size_t)m0 * 1024;
  gemm_main<AK_BF16>(acc, as, p.WB + W_OUT + (size_t)n0 * 1024, 1024, 1024, smem);
  residual_epilogue(p, acc, m0, n0, ct, l > 0 ? p.stats2 : nullptr, l > 0 ? p.ln2_g + (l - 1) * 1024 : nullptr, l > 0 ? p.ln2_b + (l - 1) * 1024 : nullptr,
                    mv + 2048, p.stats1, smem);
}
DI void phaseC3_tile(const Params& p, int l, int t, char* smem) {
  const int tid = ltid();
  const int rt = t >> 5, ct = t & 31, m0 = rt * 128, n0 = ct * 128;
  const int mi = mod_index(rt);
  const float* mv = p.modv + ((size_t)l * 9 + mi) * 6144;
  f32x16 acc[2][2];
  zero_acc(acc);
  ASrc as{};
  as.A16 = p.XN + (size_t)m0 * 1024; as.lda = 1024; as.m0 = m0;
  gemm_main<AK_BF16>(acc, as, p.WB + W_1 + (size_t)n0 * 1024, 1024, 1024, smem);
#pragma unroll 1
  for (int hf = 0; hf < 2; ++hf) {
    stage_half(acc, hf, smem);
    float v[32];
    read_staged(v, smem);
#pragma unroll
    for (int i = 0; i < 32; ++i) { float q = fmaxf(v[i], 0.f); v[i] = q * q; }
    const int R = m0 + hf * 64 + (tid >> 2);
    store_bf16_32(p.P + (size_t)R * DFF + n0 + (tid & 3) * 32, v);
  }
}
DI void phaseC4_tile(const Params& p, int l, int t, char* smem) {
  const int rt = t >> 3, ct = t & 7, m0 = rt * 128, n0 = ct * 128;
  const int mi = mod_index(rt);
  const float* mv = p.modv + ((size_t)l * 9 + mi) * 6144;
  f32x16 acc[2][2];
  zero_acc(acc);
  ASrc as{};
  as.m0 = m0; as.lda = DFF; as.A16 = p.P + (size_t)m0 * DFF;
  gemm_main<AK_BF16>(acc, as, p.WB + W_2 + (size_t)n0 * DFF, DFF, DFF, smem);
  residual_epilogue(p, acc, m0, n0, ct, p.stats1, p.ln1_g + l * 1024, p.ln1_b + l * 1024, mv + 5120, p.stats2, smem);
}
DI void phase_final(const Params& p) {
  const int tid = ltid(), wave = tid >> 6, lane = tid & 63;
  const float* g = p.ln2_g + (DEPTH - 1) * 1024;
  const float* bb = p.ln2_b + (DEPTH - 1) * 1024;
  for (int row = blockIdx.x * 4 + wave; row < NB * SEQ; row += gridDim.x * 4) {
    const int b = row >> 12, tt = row & 4095;
    const int R = b * TPB + CTXL + tt;
    const f32x4* xr = (const f32x4*)(p.X + (size_t)R * 1024);
    const f32x4 xv0 = xr[lane], xv1 = xr[lane + 64], xv2 = xr[lane + 128], xv3 = xr[lane + 192];
    float mean, rstd;
    row_stats(p.stats2, R, mean, rstd);
    float4* dst = (float4*)(p.out + (size_t)row * 1024);
#pragma unroll
    for (int j = 0; j < 4; ++j) {
      const int c4 = lane + 64 * j;
      const f32x4 vq = j == 0 ? xv0 : (j == 1 ? xv1 : (j == 2 ? xv2 : xv3));
      float4 gv = ((const float4*)g)[c4], bv = ((const float4*)bb)[c4], v = make_float4(vq.x, vq.y, vq.z, vq.w), o;
      o.x = (v.x - mean) * rstd * gv.x + bv.x; o.y = (v.y - mean) * rstd * gv.y + bv.y;
      o.z = (v.z - mean) * rstd * gv.z + bv.z; o.w = (v.w - mean) * rstd * gv.w + bv.w;
      dst[c4] = o;
    }
  }
}

DI bool swz_tile(int i, int NC, int& rt, int& ct) {
  const int G = gridDim.x;
  if ((G & 7) == 0) {
    const int x = blockIdx.x & 7, j = blockIdx.x >> 3, per = G >> 3;
    const int T8 = NROWT * NC / 8;
    const int ul = i * per + j;
    if (ul >= T8) return false;
    const int u = x * T8 + ul;
    const int band = u / (8 * NC), rem = u % (8 * NC);
    ct = rem >> 3; rt = band * 8 + (rem & 7);
    return true;
  }
  const int t = blockIdx.x + i * G;
  if (t >= NROWT * NC) return false;
  rt = t / NC; ct = t % NC;
  return true;
}

#define XB_TMO      128
#define XB_XCNT(j)  (256  + 64 * (j))
#define XB_XSUB(j)  (1280 + 64 * (j))
#define XB_XGEN(j)  (2304 + 64 * (j))
#define XB_TOP      3328
#define XB_TOPGEN   3392
#define XB_SPIN_CAP (1u << 22)
#define LAS __attribute__((address_space(3)))
DI unsigned xb_ld(unsigned* p) { return __hip_atomic_load(p, __ATOMIC_RELAXED, __HIP_MEMORY_SCOPE_AGENT); }
DI unsigned xb_add(unsigned* p, unsigned v) { return __hip_atomic_fetch_add(p, v, __ATOMIC_RELAXED, __HIP_MEMORY_SCOPE_AGENT); }
DI unsigned xb_xcc_id() { return (unsigned)__builtin_amdgcn_s_getreg((3 << 11) | 20) & 0xFu; }
#define XB_SPIN(cond, bar) do { unsigned _sp = 0; while (cond) { __builtin_amdgcn_s_sleep(1); \
    if ((++_sp & 255u) == 0u) { if (xb_ld(&(bar)[XB_TMO])) break; if (_sp > XB_SPIN_CAP) { atomicAdd(&(bar)[XB_TMO], 1u); break; } } } } while (0)
struct XcdBarrier { unsigned* bar; unsigned x; volatile LAS unsigned* st; };
DI XcdBarrier xcd_barrier_post(unsigned* bar, volatile LAS unsigned* st) {
  XcdBarrier b; b.bar = bar; b.x = xb_xcc_id(); b.st = st;
  if (threadIdx.x == 0) (void)xb_add(&bar[XB_XCNT(b.x)], 1u);
  return b;
}
DI void xcd_barrier_complete(unsigned* bar, unsigned x, unsigned& nloc, unsigned& nx) {
  const unsigned G = gridDim.x;
  unsigned sum, cnt, mine, sp = 0u;
  for (;;) {
    sum = 0u; cnt = 0u; mine = 0u;
#pragma unroll
    for (unsigned j = 0; j < 16; ++j) { const unsigned c = xb_ld(&bar[XB_XCNT(j)]); sum += c; cnt += (c > 0u) ? 1u : 0u; mine = (j == x) ? c : mine; }
    if (sum == G) break;
    __builtin_amdgcn_s_sleep(1);
    if ((++sp & 255u) == 0u) { if (xb_ld(&bar[XB_TMO])) break; if (sp > XB_SPIN_CAP) { atomicAdd(&bar[XB_TMO], 1u); break; } }
  }
  nloc = mine > 0u ? mine : 1u; nx = cnt > 0u ? cnt : 1u;
}
DI void xcd_barrier(const XcdBarrier& b) {
  asm volatile("s_waitcnt vmcnt(0)" ::: "memory");
  __syncthreads();
  if (threadIdx.x == 0) {
    unsigned* bar = b.bar;
    __builtin_amdgcn_s_waitcnt(0);
    unsigned nloc = b.st[0], nx = b.st[1];
    if (nloc == 0u) { xcd_barrier_complete(bar, b.x, nloc, nx); b.st[0] = nloc; b.st[1] = nx; }
    const unsigned old = xb_add(&bar[XB_XSUB(b.x)], 1u);
    const unsigned gen = old / nloc;
    if (old + 1u == (gen + 1u) * nloc) {
      __builtin_amdgcn_fence(__ATOMIC_RELEASE, "agent");
      asm volatile("s_waitcnt vmcnt(0)" ::: "memory");
      const unsigned og = xb_add(&bar[XB_TOP], 1u);
      const unsigned tg = og / nx;
      if (og + 1u == (tg + 1u) * nx) xb_add(&bar[XB_TOPGEN], 1u);
      else XB_SPIN(xb_ld(&bar[XB_TOPGEN]) == tg, bar);
      __builtin_amdgcn_fence(__ATOMIC_ACQUIRE, "agent");
      xb_add(&bar[XB_XGEN(b.x)], 1u);
      asm volatile("s_waitcnt vmcnt(0)" ::: "memory");
    } else {
      XB_SPIN(xb_ld(&bar[XB_XGEN(b.x)]) == gen, bar);
      __builtin_amdgcn_fence(__ATOMIC_ACQUIRE, "agent");
      asm volatile("s_waitcnt vmcnt(0)" ::: "memory");
    }
  }
  __syncthreads();
}

__global__ void __launch_bounds__(NTHREADS, 2) hybrid_fwd(Params p) {
  __shared__ __attribute__((aligned(16))) char smem[SMEM_BYTES];
  __shared__ uint4 xb_words;
  if (threadIdx.x == 0) xb_words = make_uint4(0u, 0u, 0u, 0u);
  __syncthreads();
  XcdBarrier xb{};
  bool xb_ready = false;
  for (int ph = p.phase_begin; ph < p.phase_end; ++ph) {
    if (ph == 0) phase_init0(p, smem);
    else if (ph == 1) phase_init1(p);
    else if (ph == NPHASES - 1) phase_final(p);
    else {
      const int l = (ph - 2) / NSUB, sub = (ph - 2) % NSUB;
      if (sub == 0) {
        const float* mvdummy = nullptr; (void)mvdummy;
        xn_phase(p, l > 0 ? p.stats2 : nullptr, l > 0 ? p.ln2_g + (l - 1) * 1024 : nullptr, l > 0 ? p.ln2_b + (l - 1) * 1024 : nullptr, l, 1024, 0);
        wconv_phase(p, l, smem);
      }
      else if (sub == 1) { int rt, ct; for (int i = 0; swz_tile(i, 30, rt, ct); ++i) phaseA_tile(p, l, rt * 30 + ct, smem); }
      else if (sub == 2) phaseB(p, l, smem);
      else if (sub == 3) { int rt, ct; for (int i = 0; swz_tile(i, 8, rt, ct); ++i) phaseC0_tile(p, l, (ct >= 4 ? NROWT * 4 : 0) + rt * 4 + (ct & 3), smem); }
      else if (sub == 4) { int rt, ct; for (int i = 0; swz_tile(i, 8, rt, ct); ++i) phaseC1_tile(p, l, rt * 8 + ct, smem); }
      else if (sub == 5) { int rt, ct; for (int i = 0; swz_tile(i, 8, rt, ct); ++i) phaseC2_tile(p, l, rt * 8 + ct, smem); }
      else if (sub == 6) xn_phase(p, p.stats1, p.ln1_g + l * 1024, p.ln1_b + l * 1024, l, 4096, 3072);
      else if (sub == 7) { int rt, ct; for (int i = 0; swz_tile(i, 32, rt, ct); ++i) phaseC3_tile(p, l, rt * 32 + ct, smem); }
      else { int rt, ct; for (int i = 0; swz_tile(i, 8, rt, ct); ++i) phaseC4_tile(p, l, rt * 8 + ct, smem); }
    }
    if (ph + 1 < p.phase_end) {
      if (!xb_ready) {
        cg::this_grid().sync();
        xb = xcd_barrier_post(p.bar, (volatile LAS unsigned*)&xb_words);
        xb_ready = true;
      } else {
        xcd_barrier(xb);
      }
    }
  }
}

extern "C" void kernel_launch(void* const* d_in, const int* in_sizes, int n_in, void* d_out, int out_size, void* d_ws, size_t ws_size,
                              hipStream_t stream) {
  Params p{};
  const float** pp = (const float**)&p;
  for (int i = 0; i < 40; ++i) pp[i] = (const float*)d_in[i];
  p.out = (float*)d_out;
  char* w = (char*)d_ws;
  size_t off = 0;
  auto take = [&](size_t bytes) { char* q = w + off; off += (bytes + 255) & ~(size_t)255; return q; };
  p.X = (float*)take((size_t)NTOK * 1024 * 4);
  p.P = (u16*)take((size_t)NTOK * 4096 * 2);
  p.Vt = p.P + (size_t)NTOK * PW;
  p.R2 = (u16*)take((size_t)NTOK * 1024 * 2);
  p.S5S = (u16*)take((size_t)NTOK * 512 * 2);
  p.modv = (float*)take((size_t)DEPTH * 9 * 6144 * 4);
  p.modpart = (float*)p.P;
  p.stats1 = (float*)take((size_t)NTOK * 16 * 4);
  p.stats2 = (float*)take((size_t)NTOK * 16 * 4);
  p.bonus = (float*)take((size_t)2 * NTOK * 8 * 4);
  p.rope = (float*)take(2048 * 4);
  p.ctr = (int*)take(256);
  p.bar = (unsigned*)take(XCD_BAR_WORDS * 4);
  p.cuc = (int*)take(DEPTH * 4096 * 4);
  p.WB = (u16*)d_out;
  p.XN = (u16*)((char*)d_out + (size_t)40 * 1024 * 1024);
  if (off > ws_size) { fprintf(stderr, "workspace too small: need %zu have %zu\n", off, ws_size); return; }
  static int grid_blocks = 0;
  if (!grid_blocks) {
    int dev = 0, cus = 0, per_cu = 0;
    hipGetDevice(&dev);
    hipDeviceGetAttribute(&cus, hipDeviceAttributeMultiprocessorCount, dev);
    hipOccupancyMaxActiveBlocksPerMultiprocessor(&per_cu, hybrid_fwd, NTHREADS, 0);
    if (per_cu > 2) per_cu = 2;
    grid_blocks = cus * per_cu;
  }
#if MULTI_LAUNCH
  for (int ph = 0; ph < NPHASES; ++ph) {
    p.phase_begin = ph; p.phase_end = ph + 1;
    hipLaunchKernelGGL(hybrid_fwd, dim3(grid_blocks), dim3(NTHREADS), 0, stream, p);
  }
#else
  p.phase_begin = 0; p.phase_end = NPHASES;
  void* args[] = {&p};
  hipError_t e = hipLaunchCooperativeKernel((void*)hybrid_fwd, dim3(grid_blocks), dim3(NTHREADS), args, 0, stream);
  if (e != hipSuccess) fprintf(stderr, "cooperative launch failed: %s (grid %d)\n", hipGetErrorString(e), grid_blocks);
#endif
}
```

```cpp
#include <hip/hip_runtime.h>
#include <hip/hip_cooperative_groups.h>
#include <cstdio>
#include <cstdint>
namespace cg = cooperative_groups;

#ifndef MULTI_LAUNCH
#define MULTI_LAUNCH 0
#endif

#define DI __device__ __forceinline__
typedef __attribute__((ext_vector_type(8))) short bf16x8;
typedef __attribute__((ext_vector_type(4))) short bf16x4;
typedef __attribute__((ext_vector_type(16))) float f32x16;
typedef __attribute__((ext_vector_type(4))) float f32x4;
typedef __attribute__((ext_vector_type(2))) float f2;
typedef __attribute__((ext_vector_type(2))) __bf16 bf2;
typedef unsigned short u16;
typedef __attribute__((ext_vector_type(4))) unsigned int u32x4;

constexpr int NB = 8, SEQ = 4096, CTXL = 256, TPB = 4352, NTOK = NB * TPB, DM = 1024, DEPTH = 4;
constexpr int PW = 3840;
constexpr int PC_R = 0, PC_K = 512, PC_V = 1024, PC_WD = 1536, PC_AD = 1600, PC_GD = 1664, PC_Q = 1792, PC_KK = 2816, PC_VV = 3072, PC_U = 3328;
constexpr int IN_COLS = 6912, GATE_OFF = 3840, DFF = 4096;
constexpr int NTHREADS = 256;
constexpr int SMEM_BYTES = 73728;
constexpr float ALPHA = 1.681792830507429f;
constexpr float QSCALE = 0.125f * 1.4426950408889634f;
constexpr int NROWT = NTOK / 128;
#define XCD_BAR_WORDS 3456
constexpr int NSUB = 9;
constexpr int NPHASES = 2 + NSUB * DEPTH + 1;
constexpr int W_IN = 0, W_PA = 7077888, W_PB = 7602176, W_PC = 8650752, W_OUT = 9175040, W_1 = 10223616, W_2 = 14417920, W_GUP = 18612224, W_GLU = 18677760, W_TOTAL = 18939904;

struct Params {
  const float *x, *c, *ctx, *c_ctx, *mod_w, *mod_b, *w_in, *rwkv_mu, *rwkv_w0, *rwkv_w_up, *rwkv_a0, *rwkv_a_up, *rwkv_g_up,
      *rwkv_k_k, *rwkv_k_a, *rwkv_r_k, *rwkv_gn_w, *rwkv_gn_b, *attn_q_gain, *attn_k_gain, *ssm_a_re, *ssm_a_im, *ssm_log_dt,
      *ssm_b_re, *ssm_b_im, *ssm_c_re, *ssm_c_im, *ssm_d, *ssm_glu_w, *ssm_glu_b, *proj_a, *proj_b, *proj_c, *w_out,
      *ln1_g, *ln1_b, *ln2_g, *ln2_b, *mlp_w1, *mlp_w2;
  float* out;
  float* X; u16* P; u16* Vt; u16* R2; u16* S5S; float* modv; float* modpart; float* stats1; float* stats2; float* bonus; float* rope; int* ctr; u16* WB; u16* XN; unsigned* bar; int* cuc;
  int phase_begin, phase_end;
};

DI int ltid() { int t = threadIdx.x; asm volatile("" : "+v"(t)); return t; }
DI u16 f2bf(float f) { unsigned u = __float_as_uint(f); u += 0x7fffu + ((u >> 16) & 1u); return (u16)(u >> 16); }
DI float bf2f(u16 v) { return __uint_as_float(((unsigned)v) << 16); }
DI unsigned pack2(float a, float b) { f2 v = {a, b}; bf2 c = __builtin_convertvector(v, bf2); return __builtin_bit_cast(unsigned, c); }
DI float sigm(float x) { return __builtin_amdgcn_rcpf(1.f + __expf(-x)); }
DI float tanh_fast(float x) { float e = __expf(2.f * x); return 1.f - 2.f * __builtin_amdgcn_rcpf(1.f + e); }
DI float softplus_fast(float x) { return fmaxf(x, 0.f) + __logf(1.f + __expf(-fabsf(x))); }
DI float wave_sum(float v) {
#pragma unroll
  for (int o = 32; o > 0; o >>= 1) v += __shfl_xor(v, o);
  return v;
}
DI float fma_s(float a, float b, float c) { float d; asm("v_fma_f32 %0, %1, %2, %3" : "=v"(d) : "v"(a), "v"(b), "v"(c)); return d; }
DI float mul_s(float a, float b) { float d; asm("v_mul_f32 %0, %1, %2" : "=v"(d) : "v"(a), "v"(b)); return d; }
DI float dot8_s(const float (&S)[8], float n0, float n1, float n2, float n3, float n4, float n5, float n6, float n7) {
  float pa, pb;
  asm("v_mul_f32 %0, %2, %10\n\t"
      "v_mul_f32 %1, %3, %11\n\t"
      "v_fma_f32 %0, %4, %12, %0\n\t"
      "v_fma_f32 %1, %5, %13, %1\n\t"
      "v_fma_f32 %0, %6, %14, %0\n\t"
      "v_fma_f32 %1, %7, %15, %1\n\t"
      "v_fma_f32 %0, %8, %16, %0\n\t"
      "v_fma_f32 %1, %9, %17, %1\n\t"
      "v_add_f32 %0, %0, %1"
      : "=&v"(pa), "=&v"(pb)
      : "v"(S[0]), "v"(S[1]), "v"(S[2]), "v"(S[3]), "v"(S[4]), "v"(S[5]), "v"(S[6]), "v"(S[7]),
        "v"(n0), "v"(n1), "v"(n2), "v"(n3), "v"(n4), "v"(n5), "v"(n6), "v"(n7));
  return pa;
}
DI void upd4_s(float& s0, float& s1, float& s2, float& s3, float vv, float sa,
               float kd0, float kd1, float kd2, float kd3, float ka0, float ka1, float ka2, float ka3,
               float w0, float w1, float w2, float w3) {
  float t0, t1;
  asm("v_mul_f32 %4, %6, %8\n\t"
      "v_mul_f32 %5, %6, %9\n\t"
      "v_fma_f32 %4, %7, %12, %4\n\t"
      "v_fma_f32 %5, %7, %13, %5\n\t"
      "v_fma_f32 %0, %0, %16, %4\n\t"
      "v_fma_f32 %1, %1, %17, %5\n\t"
      "v_mul_f32 %4, %6, %10\n\t"
      "v_mul_f32 %5, %6, %11\n\t"
      "v_fma_f32 %4, %7, %14, %4\n\t"
      "v_fma_f32 %5, %7, %15, %5\n\t"
      "v_fma_f32 %2, %2, %18, %4\n\t"
      "v_fma_f32 %3, %3, %19, %5"
      : "+v"(s0), "+v"(s1), "+v"(s2), "+v"(s3), "=&v"(t0), "=&v"(t1)
      : "v"(vv), "v"(sa), "v"(kd0), "v"(kd1), "v"(kd2), "v"(kd3), "v"(ka0), "v"(ka1), "v"(ka2), "v"(ka3),
        "v"(w0), "v"(w1), "v"(w2), "v"(w3));
}
DI int crow(int i, int h) { return (i & 3) + 8 * (i >> 2) + 4 * h; }
#define MFMA32(a, b, c) __builtin_amdgcn_mfma_f32_32x32x16_bf16((a), (b), (c), 0, 0, 0)
#define MFMA16(a, b, c) __builtin_amdgcn_mfma_f32_16x16x32_bf16((a), (b), (c), 0, 0, 0)

DI float lerpP(const u16* Prow, int col, bool hp, bool hn, float mu) {
  float x = bf2f(Prow[col]);
  float xp = hp ? bf2f(Prow[col - PW]) : 0.f;
  float xn = hn ? bf2f(Prow[col + PW]) : 0.f;
  return x + mu * (0.5f * (xp + xn) - x);
}

DI void unpack8(const uint4 q, float (&o)[8]) {
  o[0] = __uint_as_float(q.x << 16); o[1] = __uint_as_float(q.x & 0xffff0000u);
  o[2] = __uint_as_float(q.y << 16); o[3] = __uint_as_float(q.y & 0xffff0000u);
  o[4] = __uint_as_float(q.z << 16); o[5] = __uint_as_float(q.z & 0xffff0000u);
  o[6] = __uint_as_float(q.w << 16); o[7] = __uint_as_float(q.w & 0xffff0000u);
}
DI void lerp8(const u16* prow, int col, bool hp, bool hn, const float* mu, float (&o)[8]) {
  float x[8], xp[8], xn[8];
  unpack8(*(const uint4*)(prow + col), x);
  uint4 z = make_uint4(0, 0, 0, 0);
  unpack8(hp ? *(const uint4*)(prow + col - PW) : z, xp);
  unpack8(hn ? *(const uint4*)(prow + col + PW) : z, xn);
  float4 m0 = *(const float4*)(mu + col), m1 = *(const float4*)(mu + col + 4);
  float m[8] = {m0.x, m0.y, m0.z, m0.w, m1.x, m1.y, m1.z, m1.w};
#pragma unroll
  for (int i = 0; i < 8; ++i) o[i] = x[i] + m[i] * (0.5f * (xp[i] + xn[i]) - x[i]);
}

constexpr int GROW = 144;
constexpr int GTILE = 128 * GROW;

enum { AK_BF16 = 1, AK_GD = 2 };

struct ASrc {
  const u16* A16;
  int lda;
  const float* mu;
  int m0;
};

template <int AK>
DI void gemm_main(f32x16 (&acc)[2][2], const ASrc& as, const u16* __restrict__ BT, int ldbt, int K, char* smem) {
  const int tid = ltid(), wave = tid >> 6, lane = tid & 63, r = lane & 31, h = lane >> 5;
  const int wm = wave >> 1, wn = wave & 1;
  const int lrow = tid >> 3, lseg = tid & 7;
  const int grow = tid >> 1, ghalf = tid & 1;
  bool hp = false, hn = false;
  if (AK == AK_GD) {
    int s = (as.m0 + grow) % TPB;
    int pos = s < CTXL ? s : s - CTXL, len = s < CTXL ? CTXL : SEQ;
    hp = pos > 0; hn = pos < len - 1;
  }
  const u16* aptr = (AK == AK_BF16) ? as.A16 + (size_t)lrow * as.lda + lseg * 8 : as.A16 + (size_t)grow * PW;
  const u16* bptr = BT + (size_t)lrow * ldbt + lseg * 8;
  const size_t astep = (size_t)32 * as.lda, bstep = (size_t)32 * ldbt;
  char* const sa = smem + ((AK == AK_BF16) ? lrow * GROW + lseg * 16 : grow * GROW + ghalf * 64);
  char* const sb = smem + 2 * GTILE + lrow * GROW + lseg * 16;
  u32x4 a0_0, a0_1, a0_2, a0_3, b0_0, b0_1, b0_2, b0_3, a1_0, a1_1, a1_2, a1_3, b1_0, b1_1, b1_2, b1_3;
#define G_GD1(dst, k0, i)                                                                          \
  {                                                                                                \
    float o_[8];                                                                                   \
    lerp8(aptr, PC_GD + (k0) + ghalf * 32 + 8 * (i), hp, hn, as.mu, o_);                           \
    dst.x = pack2(sigm(o_[0]), sigm(o_[1])); dst.y = pack2(sigm(o_[2]), sigm(o_[3]));              \
    dst.z = pack2(sigm(o_[4]), sigm(o_[5])); dst.w = pack2(sigm(o_[6]), sigm(o_[7]));              \
  }
#define G_LOAD(RA, RB, k0)                                                                         \
  {                                                                                                \
    if (AK == AK_BF16) {                                                                           \
      RA##_0 = *(const u32x4*)(aptr + (k0));                                                       \
      RA##_1 = *(const u32x4*)(aptr + astep + (k0));                                               \
      RA##_2 = *(const u32x4*)(aptr + 2 * astep + (k0));                                           \
      RA##_3 = *(const u32x4*)(aptr + 3 * astep + (k0));                                           \
    } else {                                                                                       \
      G_GD1(RA##_0, k0, 0) G_GD1(RA##_1, k0, 1) G_GD1(RA##_2, k0, 2) G_GD1(RA##_3, k0, 3)          \
    }                                                                                              \
    RB##_0 = *(const u32x4*)(bptr + (k0));                                                         \
    RB##_1 = *(const u32x4*)(bptr + bstep + (k0));                                                 \
    RB##_2 = *(const u32x4*)(bptr + 2 * bstep + (k0));                                             \
    RB##_3 = *(const u32x4*)(bptr + 3 * bstep + (k0));                                             \
  }
#define G_STORE(RA, RB, buf)                                                                       \
  {                                                                                                \
    constexpr int AS_ = (AK == AK_BF16) ? 32 * GROW : 16;                                          \
    *(u32x4*)(sa + (buf) * GTILE) = RA##_0;                                                        \
    *(u32x4*)(sa + (buf) * GTILE + AS_) = RA##_1;                                                  \
    *(u32x4*)(sa + (buf) * GTILE + 2 * AS_) = RA##_2;                                              \
    *(u32x4*)(sa + (buf) * GTILE + 3 * AS_) = RA##_3;                                              \
    *(u32x4*)(sb + (buf) * GTILE) = RB##_0;                                                        \
    *(u32x4*)(sb + (buf) * GTILE + 32 * GROW) = RB##_1;                                            \
    *(u32x4*)(sb + (buf) * GTILE + 64 * GROW) = RB##_2;                                            \
    *(u32x4*)(sb + (buf) * GTILE + 96 * GROW) = RB##_3;                                            \
  }
#define G_COMPUTE(buf)                                                                             \
  {                                                                                                \
    const char* Ab = smem + (buf) * GTILE + (wm * 64 + r) * GROW + h * 16;                         \
    const char* Bb = smem + 2 * GTILE + (buf) * GTILE + (wn * 64 + r) * GROW + h * 16;             \
    __builtin_amdgcn_s_setprio(1);     \
    _Pragma("unroll") for (int k2 = 0; k2 < 4; ++k2) {                                             \
      bf16x8 fa0 = *(const bf16x8*)(Ab + k2 * 32);                                                 \
      bf16x8 fa1 = *(const bf16x8*)(Ab + 32 * GROW + k2 * 32);                                     \
      bf16x8 fb0 = *(const bf16x8*)(Bb + k2 * 32);                                                 \
      bf16x8 fb1 = *(const bf16x8*)(Bb + 32 * GROW + k2 * 32);                                     \
      acc[0][0] = MFMA32(fa0, fb0, acc[0][0]);                                                     \
      acc[0][1] = MFMA32(fa0, fb1, acc[0][1]);                                                     \
      acc[1][0] = MFMA32(fa1, fb0, acc[1][0]);                                                     \
      acc[1][1] = MFMA32(fa1, fb1, acc[1][1]);                                                     \
    }                                                                                              \
    __builtin_amdgcn_s_setprio(0);                                                                 \
  }
  const int nk = K >> 6;
  __syncthreads();
  G_LOAD(a0, b0, 0);
  G_STORE(a0, b0, 0);
  G_LOAD(a1, b1, 64);
  if (nk > 2) G_LOAD(a0, b0, 128);
  __syncthreads();
  int ks = 0;
#pragma unroll 1
  for (; ks + 6 <= nk; ks += 2) {
    G_COMPUTE(0);
    G_STORE(a1, b1, 1);
    G_LOAD(a1, b1, (ks + 3) * 64);
    __syncthreads();
    G_COMPUTE(1);
    G_STORE(a0, b0, 0);
    G_LOAD(a0, b0, (ks + 4) * 64);
    __syncthreads();
  }
  if (ks + 4 <= nk) {
    G_COMPUTE(0);
    G_STORE(a1, b1, 1);
    G_LOAD(a1, b1, (ks + 3) * 64);
    __syncthreads();
    G_COMPUTE(1);
    G_STORE(a0, b0, 0);
    __syncthreads();
    ks += 2;
  }
  G_COMPUTE(0);
  G_STORE(a1, b1, 1);
  __syncthreads();
  G_COMPUTE(1);
  __syncthreads();
#undef G_LOAD
#undef G_GD1
#undef G_STORE
#undef G_COMPUTE
}

DI void zero_acc(f32x16 (&acc)[2][2]) {
#pragma unroll
  for (int a = 0; a < 2; ++a)
#pragma unroll
    for (int b = 0; b < 2; ++b)
#pragma unroll
      for (int i = 0; i < 16; ++i) acc[a][b][i] = 0.f;
}

DI void stage_half(const f32x16 (&acc)[2][2], int hf, char* smem) {
  const int tid = ltid(), wave = tid >> 6, lane = tid & 63, r = lane & 31, h = lane >> 5;
  const int wm = wave >> 1, wn = wave & 1;
  float* st = (float*)smem;
  __syncthreads();
  if (wm == hf) {
#pragma unroll
    for (int mt = 0; mt < 2; ++mt)
#pragma unroll
      for (int nt = 0; nt < 2; ++nt)
#pragma unroll
        for (int i = 0; i < 16; ++i) st[(mt * 32 + crow(i, h)) * 132 + wn * 64 + nt * 32 + r] = acc[mt][nt][i];
  }
  __syncthreads();
}
DI void read_staged(float (&v)[32], char* smem) {
  const int tid = ltid();
  const float4* src = (const float4*)((float*)smem + (tid >> 2) * 132 + (tid & 3) * 32);
#pragma unroll
  for (int i = 0; i < 8; ++i) { float4 q = src[i]; v[4 * i] = q.x; v[4 * i + 1] = q.y; v[4 * i + 2] = q.z; v[4 * i + 3] = q.w; }
}
DI void store_bf16_32(u16* dst, const float (&v)[32]) {
  uint4* d = (uint4*)dst;
#pragma unroll
  for (int i = 0; i < 4; ++i) {
    uint4 o;
    o.x = pack2(v[8 * i], v[8 * i + 1]); o.y = pack2(v[8 * i + 2], v[8 * i + 3]);
    o.z = pack2(v[8 * i + 4], v[8 * i + 5]); o.w = pack2(v[8 * i + 6], v[8 * i + 7]);
    d[i] = o;
  }
}
DI void row_stats(const float* stats, int R, float& mean, float& rstd) {
  const float4* sp = (const float4*)(stats + (size_t)R * 16);
  float s0 = 0.f, s1 = 0.f;
#pragma unroll
  for (int i = 0; i < 4; ++i) { float4 q = sp[i]; s0 += q.x + q.z; s1 += q.y + q.w; }
  mean = s0 * (1.f / 1024.f);
  float var = s1 * (1.f / 1024.f) - mean * mean;
  rstd = rsqrtf(fmaxf(var, 0.f) + 1e-5f);
}
DI int mod_index(int rt) { int b = rt / 34, tin = rt % 34; return tin < 2 ? 8 : b; }

DI void phase_init0(const Params& p, char* smem) {
  const int tid = ltid();
  for (int i = blockIdx.x * NTHREADS + tid; i < DEPTH * 4096; i += gridDim.x * NTHREADS) p.cuc[i] = 0;
  if (blockIdx.x == 0) {
    if (tid < 64) p.ctr[tid] = 0;
    for (int i = tid; i < XCD_BAR_WORDS; i += NTHREADS) p.bar[i] = 0u;
    for (int i = tid; i < 64 * 16; i += NTHREADS) {
      int pos = i >> 4, pp = i & 15;
      float inv = powf(10000.f, -(float)pp / 16.f);
      float ang = (float)pos * inv;
      p.rope[i] = cosf(ang);
      p.rope[1024 + i] = sinf(ang);
    }
  }
  float* sc = (float*)smem;
  for (int task = blockIdx.x; task < DEPTH * 24 * 8; task += gridDim.x) {
    int kc = task & 7, jb = (task >> 3) % 24, l = task / (24 * 8);
    __syncthreads();
    for (int i = tid; i < 9 * 128; i += NTHREADS) {
      int mi = i >> 7, k = kc * 128 + (i & 127);
      float v = mi < 8 ? p.c[mi * 1024 + k] : p.c_ctx[k];
      sc[i] = v * sigm(v);
    }
    __syncthreads();
    int j = jb * 256 + tid;
    float a[9];
#pragma unroll
    for (int mi = 0; mi < 9; ++mi) a[mi] = 0.f;
    const float* w = p.mod_w + ((size_t)l * 1024 + kc * 128) * 6144 + j;
#pragma unroll 8
    for (int k = 0; k < 128; ++k) {
      float wv = w[(size_t)k * 6144];
#pragma unroll
      for (int mi = 0; mi < 9; ++mi) a[mi] += sc[mi * 128 + k] * wv;
    }
#pragma unroll
    for (int mi = 0; mi < 9; ++mi) p.modpart[(((size_t)kc * DEPTH + l) * 9 + mi) * 6144 + j] = a[mi];
  }
}
DI void phase_init1(const Params& p) {
  const int n = DEPTH * 9 * 6144;
  for (int i = blockIdx.x * NTHREADS + ltid(); i < n; i += gridDim.x * NTHREADS) {
    int j = i % 6144, l = i / (9 * 6144);
    float s = p.mod_b[l * 6144 + j];
#pragma unroll
    for (int kc = 0; kc < 8; ++kc) s += p.modpart[(size_t)kc * n + i];
    p.modv[i] = s;
  }
}

DI const float* in_row(const Params& p, int R) {
  const int b = R / TPB, s = R % TPB;
  return s < CTXL ? p.ctx + ((size_t)b * CTXL + s) * 1024 : p.x + ((size_t)b * SEQ + (s - CTXL)) * 1024;
}
DI void xn_phase(const Params& p, const float* stats, const float* g, const float* bta, int l, int sc_off, int sh_off) {
  const int tid = ltid(), wave = tid >> 6, lane = tid & 63;
  for (int row = blockIdx.x * 4 + wave; row < NTOK; row += gridDim.x * 4) {
    const int b = row / TPB, s = row % TPB;
    const int mi = s < CTXL ? 8 : b;
    const float* mv = p.modv + ((size_t)l * 9 + mi) * 6144;
    const f32x4* xr = (const f32x4*)(stats ? p.X + (size_t)row * 1024 : in_row(p, row));
    const f32x4 xv0 = xr[lane], xv1 = xr[lane + 64], xv2 = xr[lane + 128], xv3 = xr[lane + 192];
    float mean = 0.f, rstd = 1.f;
    if (stats) row_stats(stats, row, mean, rstd);
    uint2* dst = (uint2*)(p.XN + (size_t)row * 1024);
#pragma unroll
    for (int j = 0; j < 4; ++j) {
      const int c4 = lane + 64 * j;
      const f32x4 vq = j == 0 ? xv0 : (j == 1 ? xv1 : (j == 2 ? xv2 : xv3));
      float4 v = make_float4(vq.x, vq.y, vq.z, vq.w);
      if (stats) {
        float4 gv = ((const float4*)g)[c4], bv = ((const float4*)bta)[c4];
        v.x = (v.x - mean) * rstd * gv.x + bv.x; v.y = (v.y - mean) * rstd * gv.y + bv.y;
        v.z = (v.z - mean) * rstd * gv.z + bv.z; v.w = (v.w - mean) * rstd * gv.w + bv.w;
      }
      float4 sc = ((const float4*)(mv + sc_off))[c4], sh = ((const float4*)(mv + sh_off))[c4];
      uint2 o;
      o.x = pack2(v.x * (1.f + sc.x) + sh.x, v.y * (1.f + sc.y) + sh.y);
      o.y = pack2(v.z * (1.f + sc.z) + sh.z, v.w * (1.f + sc.w) + sh.w);
      dst[c4] = o;
    }
  }
}
DI void wconv_phase(const Params& p, int l, char* smem) {
  const int tid = ltid();
  float* tl = (float*)smem;
  constexpr int NT = 1728 + 128 + 256 + 128 + 256 + 1024 + 1024 + 16 + 64;
  for (int t = blockIdx.x; t < NT; t += gridDim.x) {
    const float* src; int K, N, doff, tt = t;
    if (tt < 1728) { src = p.w_in + (size_t)l * 1024 * IN_COLS; K = 1024; N = IN_COLS; doff = W_IN; }
    else if ((tt -= 1728) < 128) { src = p.proj_a + (size_t)l * 512 * 1024; K = 512; N = 1024; doff = W_PA; }
    else if ((tt -= 128) < 256) { src = p.proj_b + (size_t)l * 1024 * 1024; K = 1024; N = 1024; doff = W_PB; }
    else if ((tt -= 256) < 128) { src = p.proj_c + (size_t)l * 512 * 1024; K = 512; N = 1024; doff = W_PC; }
    else if ((tt -= 128) < 256) { src = p.w_out + (size_t)l * 1024 * 1024; K = 1024; N = 1024; doff = W_OUT; }
    else if ((tt -= 256) < 1024) { src = p.mlp_w1 + (size_t)l * 1024 * DFF; K = 1024; N = DFF; doff = W_1; }
    else if ((tt -= 1024) < 1024) { src = p.mlp_w2 + (size_t)l * DFF * 1024; K = DFF; N = 1024; doff = W_2; }
    else if ((tt -= 1024) < 16) { src = p.rwkv_g_up + (size_t)l * 128 * 512; K = 128; N = 512; doff = W_GUP; }
    else { tt -= 16; src = p.ssm_glu_w + (size_t)l * 512 * 512; K = 512; N = 512; doff = W_GLU; }
    const int ntn = N >> 6;
    const int k0 = (tt / ntn) * 64, n0 = (tt % ntn) * 64;
    __syncthreads();
#pragma unroll
    for (int i = 0; i < 4; ++i) {
      int k = (tid >> 4) + 16 * i, n4 = (tid & 15) * 4;
      float4 v = *(const float4*)(src + (size_t)(k0 + k) * N + n0 + n4);
      tl[k * 65 + n4] = v.x; tl[k * 65 + n4 + 1] = v.y; tl[k * 65 + n4 + 2] = v.z; tl[k * 65 + n4 + 3] = v.w;
    }
    __syncthreads();
    const int n = tid >> 2, kseg = (tid & 3) * 16;
    uint4 o0, o1;
    o0.x = pack2(tl[(kseg + 0) * 65 + n], tl[(kseg + 1) * 65 + n]); o0.y = pack2(tl[(kseg + 2) * 65 + n], tl[(kseg + 3) * 65 + n]);
    o0.z = pack2(tl[(kseg + 4) * 65 + n], tl[(kseg + 5) * 65 + n]); o0.w = pack2(tl[(kseg + 6) * 65 + n], tl[(kseg + 7) * 65 + n]);
    o1.x = pack2(tl[(kseg + 8) * 65 + n], tl[(kseg + 9) * 65 + n]); o1.y = pack2(tl[(kseg + 10) * 65 + n], tl[(kseg + 11) * 65 + n]);
    o1.z = pack2(tl[(kseg + 12) * 65 + n], tl[(kseg + 13) * 65 + n]); o1.w = pack2(tl[(kseg + 14) * 65 + n], tl[(kseg + 15) * 65 + n]);
    uint4* dst = (uint4*)(p.WB + doff + (size_t)(n0 + n) * K + k0 + kseg);
    dst[0] = o0; dst[1] = o1;
  }
}

DI void phaseA_tile(const Params& p, int l, int t, char* smem) {
  const int rt = t / 30, ct = t % 30, m0 = rt * 128, n0 = ct * 128;
  const int tid = ltid();
  const int mi = mod_index(rt);
  const float* mv = p.modv + ((size_t)l * 9 + mi) * 6144;
  f32x16 acc[2][2];
  zero_acc(acc);
  ASrc as{};
  as.A16 = p.XN + (size_t)m0 * 1024; as.lda = 1024; as.m0 = m0;
  gemm_main<AK_BF16>(acc, as, p.WB + W_IN + (size_t)n0 * 1024, 1024, 1024, smem);
  const int b = rt / 34;
#pragma unroll 1
  for (int hf = 0; hf < 2; ++hf) {
    stage_half(acc, hf, smem);
    if (ct == 24 || ct == 25) {
      const int col = tid & 127, grp = tid >> 7;
      const float* st = (const float*)smem;
      float v[32];
#pragma unroll
      for (int i = 0; i < 32; ++i) v[i] = st[(grp * 32 + i) * 132 + col];
      const int vcol = n0 - PC_VV + col, kvh = vcol >> 6, d = vcol & 63;
      const int s0 = m0 + hf * 64 - b * TPB + grp * 32;
      store_bf16_32(p.Vt + ((size_t)(b * 4 + kvh) * 64 + d) * TPB + s0, v);
    } else {
      float v[32];
      read_staged(v, smem);
      const int R = m0 + hf * 64 + (tid >> 2);
      const int col0 = n0 + (tid & 3) * 32;
      if (ct >= 14 && ct < 24) {
        const bool isq = ct < 22;
        const int hd = (col0 - PC_Q) & 63;
        float ss = 0.f;
#pragma unroll
        for (int i = 0; i < 32; ++i) ss += v[i] * v[i];
        ss += __shfl_xor(ss, 1);
        float rinv = rsqrtf(ss * (1.f / 64.f) + 1e-6f);
        const float* gain = (isq ? p.attn_q_gain : p.attn_k_gain) + l * 64 + hd;
#pragma unroll
        for (int i = 0; i < 32; ++i) v[i] = v[i] * rinv * gain[i];
        const int s = R % TPB;
        if (s >= CTXL) {
          const int tt = s - CTXL;
          const int pos = (hd == 0) ? (tt >> 6) : (tt & 63);
          const float* rc = p.rope + pos * 16;
#pragma unroll
          for (int i = 0; i < 16; ++i) {
            float c = rc[i], sn = rc[1024 + i];
            float a = v[i], bb = v[i + 16];
            v[i] = a * c - bb * sn;
            v[i + 16] = bb * c + a * sn;
          }
        }
        if (isq) {
#pragma unroll
          for (int i = 0; i < 32; ++i) v[i] *= QSCALE;
        }
      }
      store_bf16_32(p.P + (size_t)R * PW + col0, v);
    }
  }
}

#define DPPF(v, ctrl) __int_as_float(__builtin_amdgcn_update_dpp(0, __float_as_int(v), (ctrl), 0xf, 0xf, true))
DI float red8(float v) {
  v += DPPF(v, 0xB1);
  v += DPPF(v, 0x4E);
  v += DPPF(v, 0x141);
  return v;
}
DI float red16(float v) {
  v += DPPF(v, 0xB1);
  v += DPPF(v, 0x4E);
  v += DPPF(v, 0x141);
  v += DPPF(v, 0x140);
  return v;
}
DI void dot4x2_s(const float (&A)[4], const float (&B)[4], float n0, float n1, float n2, float n3, float& pa, float& pb) {
  asm("v_mul_f32 %0, %2, %10\n\t"
      "v_mul_f32 %1, %6, %10\n\t"
      "v_fma_f32 %0, %3, %11, %0\n\t"
      "v_fma_f32 %1, %7, %11, %1\n\t"
      "v_fma_f32 %0, %4, %12, %0\n\t"
      "v_fma_f32 %1, %8, %12, %1\n\t"
      "v_fma_f32 %0, %5, %13, %0\n\t"
      "v_fma_f32 %1, %9, %13, %1"
      : "=&v"(pa), "=&v"(pb)
      : "v"(A[0]), "v"(A[1]), "v"(A[2]), "v"(A[3]), "v"(B[0]), "v"(B[1]), "v"(B[2]), "v"(B[3]), "v"(n0), "v"(n1), "v"(n2), "v"(n3));
}
DI void upd4x2_s(float (&A)[4], float (&B)[4], float va, float vb, float saa, float sab,
                 float kd0, float kd1, float kd2, float kd3, float ka0, float ka1, float ka2, float ka3,
                 float w0, float w1, float w2, float w3) {
  float t0, t1;
  asm("v_mul_f32 %8, %10, %14\n\t"  "v_mul_f32 %9, %11, %14\n\t"
      "v_fma_f32 %8, %12, %18, %8\n\t"  "v_fma_f32 %9, %13, %18, %9\n\t"
      "v_fma_f32 %0, %0, %22, %8\n\t"  "v_fma_f32 %4, %4, %22, %9\n\t"
      "v_mul_f32 %8, %10, %15\n\t"  "v_mul_f32 %9, %11, %15\n\t"
      "v_fma_f32 %8, %12, %19, %8\n\t"  "v_fma_f32 %9, %13, %19, %9\n\t"
      "v_fma_f32 %1, %1, %23, %8\n\t"  "v_fma_f32 %5, %5, %23, %9\n\t"
      "v_mul_f32 %8, %10, %16\n\t"  "v_mul_f32 %9, %11, %16\n\t"
      "v_fma_f32 %8, %12, %20, %8\n\t"  "v_fma_f32 %9, %13, %20, %9\n\t"
      "v_fma_f32 %2, %2, %24, %8\n\t"  "v_fma_f32 %6, %6, %24, %9\n\t"
      "v_mul_f32 %8, %10, %17\n\t"  "v_mul_f32 %9, %11, %17\n\t"
      "v_fma_f32 %8, %12, %21, %8\n\t"  "v_fma_f32 %9, %13, %21, %9\n\t"
      "v_fma_f32 %3, %3, %25, %8\n\t"  "v_fma_f32 %7, %7, %25, %9"
      : "+v"(A[0]), "+v"(A[1]), "+v"(A[2]), "+v"(A[3]), "+v"(B[0]), "+v"(B[1]), "+v"(B[2]), "+v"(B[3]), "=&v"(t0), "=&v"(t1)
      : "v"(va), "v"(vb), "v"(saa), "v"(sab), "v"(kd0), "v"(kd1), "v"(kd2), "v"(kd3), "v"(ka0), "v"(ka1), "v"(ka2), "v"(ka3),
        "v"(w0), "v"(w1), "v"(w2), "v"(w3));
}
constexpr int RC = 32;
DI void rwkv_job(const Params& p, int l, int job, char* smem) {
  const int half = job & 1, jb = job >> 1;
  const int d = jb >> 6, b = (jb >> 3) & 7, h = jb & 7;
  const int tid = ltid(), wave = tid >> 6, lane = tid & 63, r = lane & 31, hh = lane >> 5;
  float* op = (float*)smem;
  char* atw = smem + 49152;
  char* ata = smem + 49152 + 4608;
  float* cst = (float*)(smem + 49152 + 9216);
  const u16* Pb = p.P + (size_t)b * TPB * PW;
  const int pt = tid >> 3, ps = tid & 7;
  __syncthreads();
  if (tid < 64) {
    const float* mu = p.rwkv_mu + l * 1792;
    const int hc = h * 64 + tid;
    cst[tid] = mu[PC_R + hc]; cst[64 + tid] = mu[PC_K + hc]; cst[128 + tid] = mu[PC_V + hc];
    cst[192 + tid] = mu[PC_WD + tid]; cst[256 + tid] = mu[PC_AD + tid];
    cst[320 + tid] = p.rwkv_k_k[l * 512 + hc]; cst[384 + tid] = p.rwkv_k_a[l * 512 + hc]; cst[448 + tid] = p.rwkv_r_k[l * 512 + hc];
  }
  const int mm = wave >> 1, nt = wave & 1;
  bf16x8 bw[4];
  float bias;
  {
    const float* W = (mm == 0 ? p.rwkv_w_up : p.rwkv_a_up) + ((size_t)(l * 2 + d) * 64) * 512 + h * 64 + nt * 32 + r;
#pragma unroll
    for (int ks = 0; ks < 4; ++ks)
#pragma unroll
      for (int jj = 0; jj < 8; ++jj) bw[ks][jj] = (short)f2bf(W[(size_t)(16 * ks + 8 * hh + jj) * 512]);
    bias = (mm == 0 ? p.rwkv_w0 : p.rwkv_a0)[(l * 2 + d) * 512 + h * 64 + nt * 32 + r];
  }
  const int rp = lane >> 4, kg = lane & 15;
  float SA[4], SB[4];
#pragma unroll
  for (int i = 0; i < 4; ++i) { SA[i] = 0.f; SB[i] = 0.f; }
  const int myrow = 32 * half + 8 * wave + 2 * rp;
  u16* ysb = p.R2 + (size_t)d * NTOK * 512 + (size_t)b * TPB * 512 + h * 64 + myrow;

  u32x4 q_rp, q_rm, q_rn, q_kp, q_km, q_kn, q_vp, q_vm, q_vn, q_wp, q_wm, q_wn, q_ap, q_am, q_an;
  bool hp, hn;
  int ptok;
#define RW_TOK(s_, tok_, pos_, len_)                                                        \
  {                                                                                         \
    if ((s_) < CTXL) { pos_ = d ? (CTXL - 1 - (s_)) : (s_); len_ = CTXL; tok_ = pos_; }     \
    else { pos_ = d ? (SEQ - 1 - ((s_) - CTXL)) : ((s_) - CTXL); len_ = SEQ; tok_ = CTXL + pos_; } \
  }
#define RW_LD3(P_, M_, N_, col_)                                                            \
  {                                                                                         \
    const u16* a_ = prow + (col_);                                                          \
    M_ = *(const u32x4*)a_;                                                                 \
    P_ = hp ? *(const u32x4*)(a_ - PW) : (u32x4){0, 0, 0, 0};                               \
    N_ = hn ? *(const u32x4*)(a_ + PW) : (u32x4){0, 0, 0, 0};                               \
  }
#define RW_PREFETCH(c_)                                                                     \
  {                                                                                         \
    int pos_, len_;                                                                         \
    const int s_ = (c_) * RC + pt;                                                          \
    RW_TOK(s_, ptok, pos_, len_);                                                           \
    hp = pos_ > 0; hn = pos_ < len_ - 1;                                                    \
    const u16* prow = Pb + (size_t)ptok * PW;                                               \
    RW_LD3(q_rp, q_rm, q_rn, PC_R + h * 64 + ps * 8)                                        \
    RW_LD3(q_kp, q_km, q_kn, PC_K + h * 64 + ps * 8)                                        \
    RW_LD3(q_vp, q_vm, q_vn, PC_V + h * 64 + ps * 8)                                        \
    RW_LD3(q_wp, q_wm, q_wn, PC_WD + ps * 8)                                                \
    RW_LD3(q_ap, q_am, q_an, PC_AD + ps * 8)                                                \
  }
#define RW_LERP(P_, M_, N_, muoff_, o_)                                                     \
  {                                                                                         \
    float x_[8], xp_[8], xn_[8];                                                            \
    unpack8(__builtin_bit_cast(uint4, M_), x_); unpack8(__builtin_bit_cast(uint4, P_), xp_); unpack8(__builtin_bit_cast(uint4, N_), xn_); \
    const float4 m0_ = *(const float4*)(cst + (muoff_) + ps * 8), m1_ = *(const float4*)(cst + (muoff_) + ps * 8 + 4); \
    const float m_[8] = {m0_.x, m0_.y, m0_.z, m0_.w, m1_.x, m1_.y, m1_.z, m1_.w};           \
    _Pragma("unroll") for (int i_ = 0; i_ < 8; ++i_) o_[i_] = x_[i_] + m_[i_] * (0.5f * (xp_[i_] + xn_[i_]) - x_[i_]); \
  }
  RW_PREFETCH(0);
  __syncthreads();
#pragma unroll 1
  for (int c = 0; c < TPB / RC; ++c) {
    const int ctok = ptok;
    {
      float o[8];
      float* ob = op + pt * 384 + ps * 8;
      RW_LERP(q_rp, q_rm, q_rn, 0, o)
      *(float4*)(ob) = make_float4(o[0], o[1], o[2], o[3]); *(float4*)(ob + 4) = make_float4(o[4], o[5], o[6], o[7]);
      RW_LERP(q_kp, q_km, q_kn, 64, o)
      *(float4*)(ob + 128) = make_float4(o[0], o[1], o[2], o[3]); *(float4*)(ob + 132) = make_float4(o[4], o[5], o[6], o[7]);
      RW_LERP(q_vp, q_vm, q_vn, 128, o)
      *(float4*)(ob + 320) = make_float4(o[0], o[1], o[2], o[3]); *(float4*)(ob + 324) = make_float4(o[4], o[5], o[6], o[7]);
      RW_LERP(q_wp, q_wm, q_wn, 192, o)
      uint4 t4;
      t4.x = pack2(tanh_fast(o[0]), tanh_fast(o[1])); t4.y = pack2(tanh_fast(o[2]), tanh_fast(o[3])); t4.z = pack2(tanh_fast(o[4]), tanh_fast(o[5])); t4.w = pack2(tanh_fast(o[6]), tanh_fast(o[7]));
      *(uint4*)(atw + pt * 144 + ps * 16) = t4;
      RW_LERP(q_ap, q_am, q_an, 256, o)
      t4.x = pack2(o[0], o[1]); t4.y = pack2(o[2], o[3]); t4.z = pack2(o[4], o[5]); t4.w = pack2(o[6], o[7]);
      *(uint4*)(ata + pt * 144 + ps * 16) = t4;
    }
    __syncthreads();
    {
      f32x16 z;
#pragma unroll
      for (int i = 0; i < 16; ++i) z[i] = bias;
      const char* at = (mm == 0 ? atw : ata) + r * 144 + hh * 16;
#pragma unroll
      for (int ks = 0; ks < 4; ++ks) z = MFMA32(*(const bf16x8*)(at + ks * 32), bw[ks], z);
      float* ob = op + (mm == 0 ? 64 : 256) + nt * 32 + r;
#pragma unroll
      for (int i = 0; i < 16; ++i) ob[crow(i, hh) * 384] = z[i];
    }
    __syncthreads();
    {
      float* ob = op + pt * 384 + ps * 8;
      float rr[8], kx[8], wp[8], ap[8], kkc[8], kac[8], rkc[8];
#define RW_RD8(dst_, ptr_) { const float4 u0_ = *(const float4*)(ptr_), u1_ = *(const float4*)((ptr_) + 4); dst_[0] = u0_.x; dst_[1] = u0_.y; dst_[2] = u0_.z; dst_[3] = u0_.w; dst_[4] = u1_.x; dst_[5] = u1_.y; dst_[6] = u1_.z; dst_[7] = u1_.w; }
      RW_RD8(rr, ob) RW_RD8(wp, ob + 64) RW_RD8(kx, ob + 128) RW_RD8(ap, ob + 256)
      RW_RD8(kkc, cst + 320 + ps * 8) RW_RD8(kac, cst + 384 + ps * 8) RW_RD8(rkc, cst + 448 + ps * 8)
      float dec[8], kk[8], kd[8], kka[8];
      float ss = 0.f, bon = 0.f;
#pragma unroll
      for (int i = 0; i < 8; ++i) {
        dec[i] = __expf(-0.6065306597126334f * sigm(wp[i]));
        const float a = sigm(ap[i]);
        kk[i] = kx[i] * kkc[i];
        ss += kk[i] * kk[i];
        kd[i] = kx[i] * (1.f + (a - 1.f) * kac[i]);
        bon += rr[i] * kd[i] * rkc[i];
        kka[i] = a;
      }
      ss = red8(ss); bon = red8(bon);
      const float rn = rsqrtf(fmaxf(ss, 1e-24f));
#pragma unroll
      for (int i = 0; i < 8; ++i) { kk[i] *= rn; kka[i] *= kk[i]; }
      *(float4*)(ob + 64) = make_float4(dec[0], dec[1], dec[2], dec[3]); *(float4*)(ob + 68) = make_float4(dec[4], dec[5], dec[6], dec[7]);
      *(float4*)(ob + 128) = make_float4(kd[0], kd[1], kd[2], kd[3]); *(float4*)(ob + 132) = make_float4(kd[4], kd[5], kd[6], kd[7]);
      *(float4*)(ob + 192) = make_float4(-kk[0], -kk[1], -kk[2], -kk[3]); *(float4*)(ob + 196) = make_float4(-kk[4], -kk[5], -kk[6], -kk[7]);
      *(float4*)(ob + 256) = make_float4(kka[0], kka[1], kka[2], kka[3]); *(float4*)(ob + 260) = make_float4(kka[4], kka[5], kka[6], kka[7]);
      if (ps == 0 && half == 0) p.bonus[((size_t)d * NTOK + (size_t)b * TPB + ctok) * 8 + h] = bon;
    }
    if (c + 1 < TPB / RC) RW_PREFETCH(c + 1);
    __syncthreads();
#define RW_LDOPS(X, st_)                                                                     \
    {                                                                                          \
      const float* ob_ = op + (st_) * 384 + kg * 4;                                            \
      X##r0 = *(const float4*)(ob_);                                                           \
      X##w0 = *(const float4*)(ob_ + 64);                                                      \
      X##d0 = *(const float4*)(ob_ + 128);                                                     \
      X##n0 = *(const float4*)(ob_ + 192);                                                     \
      X##a0 = *(const float4*)(ob_ + 256);                                                     \
      X##vv = *(const float2*)(op + (st_) * 384 + 320 + myrow);                                \
    }
#define RW_STEP(X, st_, DOST_)                                                                 \
    {                                                                                          \
      float pa_, pb_;                                                                          \
      dot4x2_s(SA, SB, X##n0.x, X##n0.y, X##n0.z, X##n0.w, pa_, pb_);                          \
      const float saa_ = red16(pa_), sab_ = red16(pb_);                                        \
      upd4x2_s(SA, SB, X##vv.x, X##vv.y, saa_, sab_, X##d0.x, X##d0.y, X##d0.z, X##d0.w,       \
               X##a0.x, X##a0.y, X##a0.z, X##a0.w, X##w0.x, X##w0.y, X##w0.z, X##w0.w);        \
      float ya_, yb_;                                                                          \
      dot4x2_s(SA, SB, X##r0.x, X##r0.y, X##r0.z, X##r0.w, ya_, yb_);                          \
      const float yy0_ = red16(ya_), yy1_ = red16(yb_);                                        \
      const bool mine_ = kg == ((st_) & 15);          \
      ykeep0 = mine_ ? yy0_ : ykeep0; ykeep1 = mine_ ? yy1_ : ykeep1;                          \
      if ((DOST_) && ((st_) & 15) == 15) {            \
        const int s_ = c * RC + (st_) - 15 + kg;                                               \
        int tok_, pos_, len_;                                                                  \
        RW_TOK(s_, tok_, pos_, len_);                                                          \
        (void)pos_; (void)len_;                                                                \
        *(unsigned*)(ysb + (size_t)tok_ * 512) = pack2(ykeep0, ykeep1);                        \
      }                                                                                        \
    }
    {
      float4 Ar0, Aw0, Ad0, An0, Aa0, Br0, Bw0, Bd0, Bn0, Ba0;
      float2 Avv, Bvv;
      float ykeep0 = 0.f, ykeep1 = 0.f;
      RW_LDOPS(A, 0)
#pragma unroll 1
      for (int st = 0; st < RC; st += 4) {
        RW_LDOPS(B, st + 1)
        RW_STEP(A, st, 0)
        RW_LDOPS(A, st + 2)
        RW_STEP(B, st + 1, 0)
        RW_LDOPS(B, st + 3)
        RW_STEP(A, st + 2, 0)
        const int sn = st + 4 < RC ? st + 4 : RC - 1;
        RW_LDOPS(A, sn)
        RW_STEP(B, st + 3, 1)
      }
    }
#undef RW_LDOPS
#undef RW_STEP
    __syncthreads();
  }
#undef RW_TOK
#undef RW_LD3
#undef RW_PREFETCH
#undef RW_LERP
#undef RW_RD8
}

#define WAVE_LDS_SYNC() do { __builtin_amdgcn_fence(__ATOMIC_RELEASE, "wavefront"); __builtin_amdgcn_wave_barrier(); __builtin_amdgcn_fence(__ATOMIC_ACQUIRE, "wavefront"); } while (0)
DI void s5_job(const Params& p, int l, int job, char* smem) {
  const int b = job >> 3, gi = job & 7;
  const int tid = ltid(), wave = tid >> 6, lane = tid & 63;
  const int g = gi * 4 + wave;
  const int col = lane & 15, quad = lane >> 4;
  float* Bu = (float*)(smem + wave * 12800);
  u16* Xs = (u16*)(smem + wave * 12800 + 8192);
  u16* Pb = p.P + (size_t)b * TPB * PW + PC_U + g * 16;
  u16* Sb = p.S5S + (size_t)b * TPB * 512 + g * 16;
  bf16x8 cf[4];
#pragma unroll
  for (int ks = 0; ks < 4; ++ks)
#pragma unroll
    for (int j = 0; j < 8; ++j) {
      int k = 32 * ks + 8 * quad + j, n = k >> 1;
      size_t idx = ((size_t)(l * 32 + g) * 16 + col) * 64 + n;
      float v = (k & 1) == 0 ? p.ssm_c_re[idx] : -p.ssm_c_im[idx];
      cf[ks][j] = (short)f2bf(v);
    }
  const float dsk = p.ssm_d[l * 512 + g * 16 + col];
#pragma unroll 1
  for (int pass = 0; pass < 2; ++pass) {
    const int d = 1 - pass;
    const float dt = __expf(p.ssm_log_dt[(l * 2 + d) * 32 + g]);
    float abr, abi;
    {
      size_t ia = ((size_t)(l * 2 + d) * 32 + g) * 64 + lane;
      float lr = fminf(p.ssm_a_re[ia], -1e-4f), li = p.ssm_a_im[ia];
      float mag = expf(lr * dt);
      abr = mag * cosf(li * dt); abi = mag * sinf(li * dt);
    }
    bf16x8 bfr[8];
#pragma unroll
    for (int q4 = 0; q4 < 4; ++q4) {
      const int n = 16 * q4 + col;
      size_t ia = ((size_t)(l * 2 + d) * 32 + g) * 64 + n;
      float lr = fminf(p.ssm_a_re[ia], -1e-4f), li = p.ssm_a_im[ia];
      float mag = expf(lr * dt);
      float ar = mag * cosf(li * dt), ai = mag * sinf(li * dt);
      float nr = ar - 1.f, ni = ai;
      float den = lr * lr + li * li;
      float cr = (nr * lr + ni * li) / den, ci = (ni * lr - nr * li) / den;
#pragma unroll
      for (int j = 0; j < 8; ++j) {
        float vr = 0.f, vi = 0.f;
        if (quad < 2) {
          size_t ib = ((size_t)(l * 32 + g) * 64 + n) * 16 + 8 * quad + j;
          float br = p.ssm_b_re[ib], bi = p.ssm_b_im[ib];
          vr = cr * br - ci * bi; vi = cr * bi + ci * br;
        }
        bfr[q4][j] = (short)f2bf(vr);
        bfr[4 + q4][j] = (short)f2bf(vi);
      }
    }
    float xr = 0.f, xi = 0.f;
    bf16x8 ua_next = {0, 0, 0, 0, 0, 0, 0, 0};
    if (quad < 2) ua_next = *(const bf16x8*)(Pb + (size_t)((d == 0 ? 0 : CTXL - 16) + col) * PW + 8 * quad);
#pragma unroll 1
    for (int c = 0; c < TPB / 16; ++c) {
      int tlo;
      if (d == 0) tlo = 16 * c;
      else tlo = c < 16 ? (CTXL - 16 - 16 * c) : (CTXL + SEQ - 16 - 16 * (c - 16));
      bf16x8 ua = ua_next;
      {
        const int cn = c + 1 < TPB / 16 ? c + 1 : c;
        int tln;
        if (d == 0) tln = 16 * cn;
        else tln = cn < 16 ? (CTXL - 16 - 16 * cn) : (CTXL + SEQ - 16 - 16 * (cn - 16));
        if (quad < 2) ua_next = *(const bf16x8*)(Pb + (size_t)(tln + col) * PW + 8 * quad);
      }
      u16 pu[4] = {0, 0, 0, 0}, psb[4] = {0, 0, 0, 0};
      if (pass == 1) {
#pragma unroll
        for (int q = 0; q < 4; ++q) { pu[q] = Pb[(size_t)(tlo + quad * 4 + q) * PW + col]; psb[q] = Sb[(size_t)(tlo + quad * 4 + q) * 512 + col]; }
      }
#pragma unroll
      for (int nt = 0; nt < 8; ++nt) {
        f32x4 z = {0.f, 0.f, 0.f, 0.f};
        z = MFMA16(ua, bfr[nt], z);
#pragma unroll
        for (int q = 0; q < 4; ++q) Bu[(quad * 4 + q) * 128 + nt * 16 + col] = z[q];
      }
      WAVE_LDS_SYNC();
#pragma unroll
      for (int tt = 0; tt < 16; ++tt) {
        const int t = d ? 15 - tt : tt;
        float br = Bu[t * 128 + lane], bi = Bu[t * 128 + 64 + lane];
        float nr = abr * xr - abi * xi + br;
        float ni = abr * xi + abi * xr + bi;
        xr = nr; xi = ni;
        *(unsigned*)(Xs + t * 136 + 2 * lane) = pack2(xr, xi);
      }
      WAVE_LDS_SYNC();
      f32x4 y = {0.f, 0.f, 0.f, 0.f};
#pragma unroll
      for (int ks = 0; ks < 4; ++ks) {
        bf16x8 a = *(const bf16x8*)(Xs + col * 136 + 32 * ks + 8 * quad);
        y = MFMA16(a, cf[ks], y);
      }
#pragma unroll
      for (int q = 0; q < 4; ++q) {
        const int tok = tlo + quad * 4 + q;
        if (pass == 0) {
          Sb[(size_t)tok * 512 + col] = f2bf(y[q]);
        } else {
          float u = bf2f(pu[q]);
          float v = y[q] + bf2f(psb[q]) + dsk * u;
          float gl = 0.5f * v * (1.f + tanh_fast(0.7978845608028654f * (v + 0.044715f * v * v * v)));
          Pb[(size_t)tok * PW + col] = f2bf(gl);
        }
      }
      WAVE_LDS_SYNC();
    }
  }
}

DI void attn_job(const Params& p, int l, int bk, int qt, char* smem) {
  const int kvh = bk & 3, b = bk >> 2;
  const int tid = ltid(), wave = tid >> 6, lane = tid & 63, r = lane & 31, h = lane >> 5;
  const int nt = (qt < 4 ? CTXL : TPB) / 64;
  const int head = kvh * 4 + wave;
  const size_t R0 = (size_t)b * TPB + qt * 64;
  u16* Ks = (u16*)smem;
  u16* Vs = (u16*)(smem + 18432);
  bf16x8 qf[2][4];
#pragma unroll
  for (int qs = 0; qs < 2; ++qs) {
    const u16* qp = p.P + (R0 + qs * 32 + r) * PW + PC_Q + head * 64 + 8 * h;
#pragma unroll
    for (int ks = 0; ks < 4; ++ks) qf[qs][ks] = *(const bf16x8*)(qp + 16 * ks);
  }
  f32x16 ot[2][2];
#pragma unroll
  for (int i = 0; i < 16; ++i) { ot[0][0][i] = 0.f; ot[0][1][i] = 0.f; ot[1][0][i] = 0.f; ot[1][1][i] = 0.f; }
  float lp0 = 0.f, lp1 = 0.f;
  float soff;
  {
    float gq = fabsf(p.attn_q_gain[l * 64 + lane]), gk = fabsf(p.attn_k_gain[l * 64 + lane]);
#pragma unroll
    for (int o = 32; o > 0; o >>= 1) { gq = fmaxf(gq, __shfl_xor(gq, o)); gk = fmaxf(gk, __shfl_xor(gk, o)); }
    soff = 8.f * 1.4426950408889634f * gq * gk * 1.02f + 0.5f;
  }
  f32x16 negoff;
#pragma unroll
  for (int i = 0; i < 16; ++i) negoff[i] = -soff;
  const int lrow = tid >> 2, lseg = (tid & 3) * 16;
  const u16* kg = p.P + ((size_t)b * TPB + lrow) * PW + PC_KK + kvh * 64 + lseg;
  const u16* vg = p.Vt + ((size_t)(b * 4 + kvh) * 64 + lrow) * TPB + lseg;
  uint4 kr0, kr1, vr0, vr1;
#define ATT_GLOAD(t_) { const uint4* ks_ = (const uint4*)(kg + (size_t)(t_) * 64 * PW); const uint4* vs_ = (const uint4*)(vg + (t_) * 64); kr0 = ks_[0]; kr1 = ks_[1]; vr0 = vs_[0]; vr1 = vs_[1]; }
#define ATT_LSTORE(b_) { uint4* kd_ = (uint4*)(Ks + (b_) * 4608 + lrow * 72 + lseg); uint4* vd_ = (uint4*)(Vs + (b_) * 4608 + lrow * 72 + lseg); kd_[0] = kr0; kd_[1] = kr1; vd_[0] = vr0; vd_[1] = vr1; }
  __syncthreads();
  ATT_GLOAD(0); ATT_LSTORE(0);
  __syncthreads();
#pragma unroll 1
  for (int t = 0; t < nt; ++t) {
    const int bufi = t & 1;
    if (t + 1 < nt) ATT_GLOAD(t + 1);
    const u16* Kb = Ks + bufi * 4608;
    const u16* Vb = Vs + bufi * 4608;
    f32x16 st[2][2];
#pragma unroll
    for (int k2 = 0; k2 < 2; ++k2) {
#pragma unroll
      for (int ks = 0; ks < 4; ++ks) {
        bf16x8 a = *(const bf16x8*)(Kb + (k2 * 32 + r) * 72 + ks * 16 + h * 8);
        st[0][k2] = (ks == 0) ? MFMA32(a, qf[0][ks], negoff) : MFMA32(a, qf[0][ks], st[0][k2]);
        st[1][k2] = (ks == 0) ? MFMA32(a, qf[1][ks], negoff) : MFMA32(a, qf[1][ks], st[1][k2]);
      }
    }
    float ps0 = 0.f, ps1 = 0.f;
#pragma unroll
    for (int i = 0; i < 16; ++i) {
      st[0][0][i] = __builtin_amdgcn_exp2f(st[0][0][i]); st[0][1][i] = __builtin_amdgcn_exp2f(st[0][1][i]);
      st[1][0][i] = __builtin_amdgcn_exp2f(st[1][0][i]); st[1][1][i] = __builtin_amdgcn_exp2f(st[1][1][i]);
      ps0 += st[0][0][i] + st[0][1][i]; ps1 += st[1][0][i] + st[1][1][i];
    }
    lp0 += ps0; lp1 += ps1;
#pragma unroll
    for (int k2 = 0; k2 < 2; ++k2)
#pragma unroll
      for (int s = 0; s < 2; ++s) {
        uint4 pk0, pk1;
        pk0.x = pack2(st[0][k2][8 * s], st[0][k2][8 * s + 1]); pk0.y = pack2(st[0][k2][8 * s + 2], st[0][k2][8 * s + 3]);
        pk0.z = pack2(st[0][k2][8 * s + 4], st[0][k2][8 * s + 5]); pk0.w = pack2(st[0][k2][8 * s + 6], st[0][k2][8 * s + 7]);
        pk1.x = pack2(st[1][k2][8 * s], st[1][k2][8 * s + 1]); pk1.y = pack2(st[1][k2][8 * s + 2], st[1][k2][8 * s + 3]);
        pk1.z = pack2(st[1][k2][8 * s + 4], st[1][k2][8 * s + 5]); pk1.w = pack2(st[1][k2][8 * s + 6], st[1][k2][8 * s + 7]);
        const bf16x8 pb0 = __builtin_bit_cast(bf16x8, pk0), pb1 = __builtin_bit_cast(bf16x8, pk1);
#pragma unroll
        for (int dt = 0; dt < 2; ++dt) {
          const u16* vp = Vb + (dt * 32 + r) * 72 + k2 * 32 + 16 * s + 4 * h;
          bf16x4 lo = *(const bf16x4*)vp;
          bf16x4 hi = *(const bf16x4*)(vp + 8);
          bf16x8 a = __builtin_shufflevector(lo, hi, 0, 1, 2, 3, 4, 5, 6, 7);
          ot[0][dt] = MFMA32(a, pb0, ot[0][dt]);
          ot[1][dt] = MFMA32(a, pb1, ot[1][dt]);
        }
      }
    if (t + 1 < nt) ATT_LSTORE(bufi ^ 1);
    __syncthreads();
  }
#pragma unroll
  for (int qs = 0; qs < 2; ++qs) {
    const float lpart = qs == 0 ? lp0 : lp1;
    const float lsum = lpart + __shfl_xor(lpart, 32);
    const float inv = 1.f / lsum;
    u16* op = p.P + (R0 + qs * 32 + r) * PW + PC_Q + head * 64;
#pragma unroll
    for (int dt = 0; dt < 2; ++dt)
#pragma unroll
      for (int i4 = 0; i4 < 4; ++i4) {
        uint2 o;
        o.x = pack2(ot[qs][dt][4 * i4] * inv, ot[qs][dt][4 * i4 + 1] * inv);
        o.y = pack2(ot[qs][dt][4 * i4 + 2] * inv, ot[qs][dt][4 * i4 + 3] * inv);
        *(uint2*)(op + dt * 32 + 8 * i4 + 4 * h) = o;
      }
  }
}

constexpr int NJ_RWKV = 256, NJ_S5 = 64, NJ_ATT = NB * 4 * 136;
DI int fetch_job(int* ctr, int* s_job) {
  __syncthreads();
  if (ltid() == 0) *s_job = atomicAdd(ctr, 1);
  __syncthreads();
  return *s_job;
}
DI void phaseB(const Params& p, int l, char* smem) {
  __shared__ int s_job;
  __syncthreads();
  if (ltid() == 0) {
    const unsigned hw = (unsigned)__builtin_amdgcn_s_getreg((7 << 11) | (8 << 6) | 4);
    const unsigned xcc = (unsigned)__builtin_amdgcn_s_getreg((3 << 11) | 20) & 0xFu;
    const unsigned key = (xcc << 8) | (hw & 0xffu);
    s_job = atomicAdd(p.cuc + l * 4096 + (int)key, 1);
  }
  __syncthreads();
  const int slot = s_job;
  if (slot == 0) {
    const int job = fetch_job(p.ctr + l, &s_job);
    if (job < NJ_RWKV) { __builtin_amdgcn_s_setprio(3); rwkv_job(p, l, job, smem); __builtin_amdgcn_s_setprio(0); }
  } else {
    const int job = fetch_job(p.ctr + 4 + l, &s_job);
    if (job < NJ_S5) { __builtin_amdgcn_s_setprio(2); s5_job(p, l, job, smem); __builtin_amdgcn_s_setprio(0); }
  }
  const int x = blockIdx.x & 7;
#pragma unroll 1
  for (int k = 0; k < 8; ++k) {
    const int xq = (x + k) & 7;
    for (;;) {
      const int n = fetch_job(p.ctr + 8 + l * 8 + xq, &s_job);
      if (n >= 4 * 68) break;
      attn_job(p, l, xq * 4 + n / 68, 67 - (n % 68), smem);
    }
  }
  for (;;) {
    const int job = fetch_job(p.ctr + l, &s_job);
    if (job >= NJ_RWKV) break;
    rwkv_job(p, l, job, smem);
  }
  for (;;) {
    const int job = fetch_job(p.ctr + 4 + l, &s_job);
    if (job >= NJ_S5) break;
    s5_job(p, l, job, smem);
  }
}

DI void phaseC0_tile(const Params& p, int l, int t, char* smem) {
  const int tid = ltid();
  const bool glu = t >= NROWT * 4;
  if (glu) t -= NROWT * 4;
  const int rt = t >> 2, ct = t & 3, m0 = rt * 128, n0 = ct * 128;
  f32x16 acc[2][2];
  zero_acc(acc);
  ASrc as{};
  as.m0 = m0;
  if (!glu) {
    as.A16 = p.P + (size_t)m0 * PW; as.mu = p.rwkv_mu + l * 1792;
    gemm_main<AK_GD>(acc, as, p.WB + W_GUP + (size_t)n0 * 128, 128, 128, smem);
  } else {
    as.A16 = p.P + (size_t)m0 * PW + PC_U; as.lda = PW;
    gemm_main<AK_BF16>(acc, as, p.WB + W_GLU + (size_t)n0 * 512, 512, 512, smem);
  }
#pragma unroll 1
  for (int hf = 0; hf < 2; ++hf) {
    stage_half(acc, hf, smem);
    const int R = m0 + hf * 64 + (tid >> 2);
    const int col0 = n0 + (tid & 3) * 32;
    const u16* prow = p.P + (size_t)R * PW;
    const float* srow = (const float*)smem + (tid >> 2) * 132 + (tid & 3) * 32;
    if (!glu) {
      const int hd = col0 >> 6;
      const u16* y0 = p.R2 + (size_t)R * 512 + col0;
      const u16* y1 = y0 + (size_t)NTOK * 512;
      float s0 = 0.f, s1 = 0.f;
#pragma unroll 1
      for (int c8 = 0; c8 < 4; ++c8) {
        float a[8], bq[8];
        unpack8(*(const uint4*)(y0 + 8 * c8), a);
        unpack8(*(const uint4*)(y1 + 8 * c8), bq);
#pragma unroll
        for (int i = 0; i < 8; ++i) { float y = a[i] + bq[i]; s0 += y; s1 += y * y; }
      }
      s0 += __shfl_xor(s0, 1); s1 += __shfl_xor(s1, 1);
      const float mean = s0 * (1.f / 64.f);
      const float var = fmaxf(s1 * (1.f / 64.f) - mean * mean, 0.f);
      const float rstd = rsqrtf(var + 64e-5f);
      const float bon = p.bonus[(size_t)R * 8 + hd] + p.bonus[((size_t)NTOK + R) * 8 + hd];
      const int s = R % TPB;
      const int pos = s < CTXL ? s : s - CTXL, len = s < CTXL ? CTXL : SEQ;
      const bool hp = pos > 0, hn = pos < len - 1;
      const float* mu = p.rwkv_mu + l * 1792;
      const float* gw = p.rwkv_gn_w + l * 512 + col0;
      const float* gb = p.rwkv_gn_b + l * 512 + col0;
#pragma unroll 1
      for (int c8 = 0; c8 < 4; ++c8) {
        float a[8], bq[8], vx[8], o[8];
        unpack8(*(const uint4*)(y0 + 8 * c8), a);
        unpack8(*(const uint4*)(y1 + 8 * c8), bq);
        lerp8(prow, PC_V + col0 + 8 * c8, hp, hn, mu, vx);
        float4 g0 = *(const float4*)(srow + 8 * c8), g1 = *(const float4*)(srow + 8 * c8 + 4);
        float gt[8] = {g0.x, g0.y, g0.z, g0.w, g1.x, g1.y, g1.z, g1.w};
#pragma unroll
        for (int i = 0; i < 8; ++i) {
          float yn = (a[i] + bq[i] - mean) * rstd * gw[8 * c8 + i] + gb[8 * c8 + i];
          o[i] = (yn + bon * vx[i]) * gt[i];
        }
        uint4 q;
        q.x = pack2(o[0], o[1]); q.y = pack2(o[2], o[3]); q.z = pack2(o[4], o[5]); q.w = pack2(o[6], o[7]);
        *(uint4*)(p.P + (size_t)R * PW + PC_R + col0 + 8 * c8) = q;
      }
    } else {
      const float* gb = p.ssm_glu_b + l * 512 + col0;
#pragma unroll 1
      for (int c8 = 0; c8 < 4; ++c8) {
        float yv[8], o[8];
        unpack8(*(const uint4*)(prow + PC_U + col0 + 8 * c8), yv);
        float4 g0 = *(const float4*)(srow + 8 * c8), g1 = *(const float4*)(srow + 8 * c8 + 4);
        float gt[8] = {g0.x, g0.y, g0.z, g0.w, g1.x, g1.y, g1.z, g1.w};
#pragma unroll
        for (int i = 0; i < 8; ++i) o[i] = yv[i] * sigm(gt[i] + gb[8 * c8 + i]);
        uint4 q;
        q.x = pack2(o[0], o[1]); q.y = pack2(o[2], o[3]); q.z = pack2(o[4], o[5]); q.w = pack2(o[6], o[7]);
        *(uint4*)(p.P + (size_t)R * PW + PC_K + col0 + 8 * c8) = q;
      }
    }
  }
}

DI void phaseC1_tile(const Params& p, int l, int t, char* smem) {
  const int tid = ltid();
  const int rt = t >> 3, ct = t & 7, m0 = rt * 128, n0 = ct * 128;
  const int mi = mod_index(rt);
  const float* mv = p.modv + ((size_t)l * 9 + mi) * 6144;
#pragma unroll 1
  for (int br = 0; br < 3; ++br) {
    {
      unsigned sg[2][2][8];
      f32x16 acc[2][2];
      zero_acc(acc);
      ASrc as{};
      as.A16 = p.XN + (size_t)m0 * 1024; as.lda = 1024; as.m0 = m0;
      gemm_main<AK_BF16>(acc, as, p.WB + W_IN + (size_t)(GATE_OFF + br * 1024 + n0) * 1024, 1024, 1024, smem);
#pragma unroll
      for (int a = 0; a < 2; ++a)
#pragma unroll
        for (int bq = 0; bq < 2; ++bq)
#pragma unroll
          for (int i = 0; i < 8; ++i) sg[a][bq][i] = pack2(sigm(acc[a][bq][2 * i]), sigm(acc[a][bq][2 * i + 1]));
      uint4* gs = (uint4*)p.S5S + (size_t)blockIdx.x * 8 * NTHREADS + tid;
#pragma unroll
      for (int a = 0; a < 2; ++a)
#pragma unroll
        for (int bq = 0; bq < 2; ++bq) {
          gs[((a * 2 + bq) * 2 + 0) * NTHREADS] = make_uint4(sg[a][bq][0], sg[a][bq][1], sg[a][bq][2], sg[a][bq][3]);
          gs[((a * 2 + bq) * 2 + 1) * NTHREADS] = make_uint4(sg[a][bq][4], sg[a][bq][5], sg[a][bq][6], sg[a][bq][7]);
        }
    }
    f32x16 acc[2][2];
    zero_acc(acc);
    ASrc as{};
    as.m0 = m0; as.lda = PW;
    const u16* Bp; int K;
    if (br == 0) { as.A16 = p.P + (size_t)m0 * PW + PC_R; Bp = p.WB + W_PA; K = 512; }
    else if (br == 1) { as.A16 = p.P + (size_t)m0 * PW + PC_Q; Bp = p.WB + W_PB; K = 1024; }
    else { as.A16 = p.P + (size_t)m0 * PW + PC_K; Bp = p.WB + W_PC; K = 512; }
    gemm_main<AK_BF16>(acc, as, Bp + (size_t)n0 * K, K, K, smem);
#pragma unroll
    for (int a = 0; a < 2; ++a)
#pragma unroll
      for (int bq = 0; bq < 2; ++bq)
      {
        const uint4* gs = (const uint4*)p.S5S + (size_t)blockIdx.x * 8 * NTHREADS + tid;
        const uint4 g0 = gs[((a * 2 + bq) * 2 + 0) * NTHREADS], g1 = gs[((a * 2 + bq) * 2 + 1) * NTHREADS];
        const unsigned gu[8] = {g0.x, g0.y, g0.z, g0.w, g1.x, g1.y, g1.z, g1.w};
#pragma unroll
        for (int i = 0; i < 8; ++i) {
          acc[a][bq][2 * i] *= __uint_as_float(gu[i] << 16);
          acc[a][bq][2 * i + 1] *= __uint_as_float(gu[i] & 0xffff0000u);
        }
      }
#pragma unroll 1
    for (int hf = 0; hf < 2; ++hf) {
      stage_half(acc, hf, smem);
      const int R = m0 + hf * 64 + (tid >> 2);
      u16* dst = p.R2 + (size_t)R * 1024 + n0 + (tid & 3) * 32;
      const float* srow = (const float*)smem + (tid >> 2) * 132 + (tid & 3) * 32;
#pragma unroll 1
      for (int c8 = 0; c8 < 4; ++c8) {
        float4 g0 = *(const float4*)(srow + 8 * c8), g1 = *(const float4*)(srow + 8 * c8 + 4);
        float o[8] = {g0.x, g0.y, g0.z, g0.w, g1.x, g1.y, g1.z, g1.w};
        if (br > 0) {
          float prev[8];
          unpack8(*(const uint4*)(dst + 8 * c8), prev);
#pragma unroll
          for (int i = 0; i < 8; ++i) o[i] += prev[i];
        }
        uint4 q;
        q.x = pack2(o[0], o[1]); q.y = pack2(o[2], o[3]); q.z = pack2(o[4], o[5]); q.w = pack2(o[6], o[7]);
        *(uint4*)(dst + 8 * c8) = q;
      }
    }
    __syncthreads();
  }
}

DI void residual_epilogue(const Params& p, const f32x16 (&acc)[2][2], int m0, int n0, int ct, const float* stats_in, const float* g_in, const float* b_in,
                          const float* gate, float* stats_out, char* smem) {
  const int tid = ltid();
#pragma unroll 1
  for (int hf = 0; hf < 2; ++hf) {
    stage_half(acc, hf, smem);
    float v[32];
    read_staged(v, smem);
    const int R = m0 + hf * 64 + (tid >> 2);
    const int col0 = n0 + (tid & 3) * 32;
    float mean = 0.f, rstd = 1.f;
    if (stats_in) row_stats(stats_in, R, mean, rstd);
    float4* xp = (float4*)(p.X + (size_t)R * 1024 + col0);
    const float4* xsrc = stats_in ? (const float4*)xp : (const float4*)(in_row(p, R) + col0);
    float s0 = 0.f, s1 = 0.f;
#pragma unroll
    for (int i = 0; i < 8; ++i) {
      float4 xv = xsrc[i];
      float xin[4] = {xv.x, xv.y, xv.z, xv.w};
      float o[4];
#pragma unroll
      for (int j = 0; j < 4; ++j) {
        int cc = col0 + 4 * i + j;
        float xi = xin[j];
        if (stats_in) xi = (xi - mean) * rstd * g_in[cc] + b_in[cc];
        float val = ALPHA * xi + gate[cc] * v[4 * i + j];
        o[j] = val; s0 += val; s1 += val * val;
      }
      xp[i] = make_float4(o[0], o[1], o[2], o[3]);
    }
    s0 += __shfl_xor(s0, 1); s1 += __shfl_xor(s1, 1);
    s0 += __shfl_xor(s0, 2); s1 += __shfl_xor(s1, 2);
    if ((tid & 3) == 0) { stats_out[(size_t)R * 16 + ct * 2] = s0; stats_out[(size_t)R * 16 + ct * 2 + 1] = s1; }
  }
}

DI void phaseC2_tile(const Params& p, int l, int t, char* smem) {
  const int rt = t >> 3, ct = t & 7, m0 = rt * 128, n0 = ct * 128;
  const int mi = mod_index(rt);
  const float* mv = p.modv + ((size_t)l * 9 + mi) * 6144;
  f32x16 acc[2][2];
  zero_acc(acc);
  ASrc as{};
  as.m0 = m0; as.lda = 1024; as.A16 = p.R2 + (size_t)m0 * 1024;
  gemm_main<AK_BF16>(acc, as, p.WB + W_OUT + (size_t)n0 * 1024, 1024, 1024, smem);
  residual_epilogue(p, acc, m0, n0, ct, l > 0 ? p.stats2 : nullptr, l > 0 ? p.ln2_g + (l - 1) * 1024 : nullptr, l > 0 ? p.ln2_b + (l - 1) * 1024 : nullptr,
                    mv + 2048, p.stats1, smem);
}
DI void phaseC3_tile(const Params& p, int l, int t, char* smem) {
  const int tid = ltid();
  const int rt = t >> 5, ct = t & 31, m0 = rt * 128, n0 = ct * 128;
  const int mi = mod_index(rt);
  const float* mv = p.modv + ((size_t)l * 9 + mi) * 6144;
  f32x16 acc[2][2];
  zero_acc(acc);
  ASrc as{};
  as.A16 = p.XN + (size_t)m0 * 1024; as.lda = 1024; as.m0 = m0;
  gemm_main<AK_BF16>(acc, as, p.WB + W_1 + (size_t)n0 * 1024, 1024, 1024, smem);
#pragma unroll 1
  for (int hf = 0; hf < 2; ++hf) {
    stage_half(acc, hf, smem);
    float v[32];
    read_staged(v, smem);
#pragma unroll
    for (int i = 0; i < 32; ++i) { float q = fmaxf(v[i], 0.f); v[i] = q * q; }
    const int R = m0 + hf * 64 + (tid >> 2);
    store_bf16_32(p.P + (size_t)R * DFF + n0 + (tid & 3) * 32, v);
  }
}
DI void phaseC4_tile(const Params& p, int l, int t, char* smem) {
  const int rt = t >> 3, ct = t & 7, m0 = rt * 128, n0 = ct * 128;
  const int mi = mod_index(rt);
  const float* mv = p.modv + ((size_t)l * 9 + mi) * 6144;
  f32x16 acc[2][2];
  zero_acc(acc);
  ASrc as{};
  as.m0 = m0; as.lda = DFF; as.A16 = p.P + (size_t)m0 * DFF;
  gemm_main<AK_BF16>(acc, as, p.WB + W_2 + (size_t)n0 * DFF, DFF, DFF, smem);
  residual_epilogue(p, acc, m0, n0, ct, p.stats1, p.ln1_g + l * 1024, p.ln1_b + l * 1024, mv + 5120, p.stats2, smem);
}
DI void phase_final(const Params& p) {
  const int tid = ltid(), wave = tid >> 6, lane = tid & 63;
  const float* g = p.ln2_g + (DEPTH - 1) * 1024;
  const float* bb = p.ln2_b + (DEPTH - 1) * 1024;
  for (int row = blockIdx.x * 4 + wave; row < NB * SEQ; row += gridDim.x * 4) {
    const int b = row >> 12, tt = row & 4095;
    const int R = b * TPB + CTXL + tt;
    const f32x4* xr = (const f32x4*)(p.X + (size_t)R * 1024);
    const f32x4 xv0 = xr[lane], xv1 = xr[lane + 64], xv2 = xr[lane + 128], xv3 = xr[lane + 192];
    float mean, rstd;
    row_stats(p.stats2, R, mean, rstd);
    float4* dst = (float4*)(p.out + (size_t)row * 1024);
#pragma unroll
    for (int j = 0; j < 4; ++j) {
      const int c4 = lane + 64 * j;
      const f32x4 vq = j == 0 ? xv0 : (j == 1 ? xv1 : (j == 2 ? xv2 : xv3));
      float4 gv = ((const float4*)g)[c4], bv = ((const float4*)bb)[c4], v = make_float4(vq.x, vq.y, vq.z, vq.w), o;
      o.x = (v.x - mean) * rstd * gv.x + bv.x; o.y = (v.y - mean) * rstd * gv.y + bv.y;
      o.z = (v.z - mean) * rstd * gv.z + bv.z; o.w = (v.w - mean) * rstd * gv.w + bv.w;
      dst[c4] = o;
    }
  }
}

DI bool swz_tile(int i, int NC, int& rt, int& ct) {
  const int G = gridDim.x;
  if ((G & 7) == 0) {
    const int x = blockIdx.x & 7, j = blockIdx.x >> 3, per = G >> 3;
    const int T8 = NROWT * NC / 8;
    const int ul = i * per + j;
    if (ul >= T8) return false;
    const int u = x * T8 + ul;
    const int band = u / (8 * NC), rem = u % (8 * NC);
    ct = rem >> 3; rt = band * 8 + (rem & 7);
    return true;
  }
  const int t = blockIdx.x + i * G;
  if (t >= NROWT * NC) return false;
  rt = t / NC; ct = t % NC;
  return true;
}

#define XB_TMO      128
#define XB_XCNT(j)  (256  + 64 * (j))
#define XB_XSUB(j)  (1280 + 64 * (j))
#define XB_XGEN(j)  (2304 + 64 * (j))
#define XB_TOP      3328
#define XB_TOPGEN   3392
#define XB_SPIN_CAP (1u << 22)
#define LAS __attribute__((address_space(3)))
DI unsigned xb_ld(unsigned* p) { return __hip_atomic_load(p, __ATOMIC_RELAXED, __HIP_MEMORY_SCOPE_AGENT); }
DI unsigned xb_add(unsigned* p, unsigned v) { return __hip_atomic_fetch_add(p, v, __ATOMIC_RELAXED, __HIP_MEMORY_SCOPE_AGENT); }
DI unsigned xb_xcc_id() { return (unsigned)__builtin_amdgcn_s_getreg((3 << 11) | 20) & 0xFu; }
#define XB_SPIN(cond, bar) do { unsigned _sp = 0; while (cond) { __builtin_amdgcn_s_sleep(1); \
    if ((++_sp & 255u) == 0u) { if (xb_ld(&(bar)[XB_TMO])) break; if (_sp > XB_SPIN_CAP) { atomicAdd(&(bar)[XB_TMO], 1u); break; } } } } while (0)
struct XcdBarrier { unsigned* bar; unsigned x; volatile LAS unsigned* st; };
DI XcdBarrier xcd_barrier_post(unsigned* bar, volatile LAS unsigned* st) {
  XcdBarrier b; b.bar = bar; b.x = xb_xcc_id(); b.st = st;
  if (threadIdx.x == 0) (void)xb_add(&bar[XB_XCNT(b.x)], 1u);
  return b;
}
DI void xcd_barrier_complete(unsigned* bar, unsigned x, unsigned& nloc, unsigned& nx) {
  const unsigned G = gridDim.x;
  unsigned sum, cnt, mine, sp = 0u;
  for (;;) {
    sum = 0u; cnt = 0u; mine = 0u;
#pragma unroll
    for (unsigned j = 0; j < 16; ++j) { const unsigned c = xb_ld(&bar[XB_XCNT(j)]); sum += c; cnt += (c > 0u) ? 1u : 0u; mine = (j == x) ? c : mine; }
    if (sum == G) break;
    __builtin_amdgcn_s_sleep(1);
    if ((++sp & 255u) == 0u) { if (xb_ld(&bar[XB_TMO])) break; if (sp > XB_SPIN_CAP) { atomicAdd(&bar[XB_TMO], 1u); break; } }
  }
  nloc = mine > 0u ? mine : 1u; nx = cnt > 0u ? cnt : 1u;
}
DI void xcd_barrier(const XcdBarrier& b) {
  asm volatile("s_waitcnt vmcnt(0)" ::: "memory");
  __syncthreads();
  if (threadIdx.x == 0) {
    unsigned* bar = b.bar;
    __builtin_amdgcn_s_waitcnt(0);
    unsigned nloc = b.st[0], nx = b.st[1];
    if (nloc == 0u) { xcd_barrier_complete(bar, b.x, nloc, nx); b.st[0] = nloc; b.st[1] = nx; }
    const unsigned old = xb_add(&bar[XB_XSUB(b.x)], 1u);
    const unsigned gen = old / nloc;
    if (old + 1u == (gen + 1u) * nloc) {
      __builtin_amdgcn_fence(__ATOMIC_RELEASE, "agent");
      asm volatile("s_waitcnt vmcnt(0)" ::: "memory");
      const unsigned og = xb_add(&bar[XB_TOP], 1u);
      const unsigned tg = og / nx;
      if (og + 1u == (tg + 1u) * nx) xb_add(&bar[XB_TOPGEN], 1u);
      else XB_SPIN(xb_ld(&bar[XB_TOPGEN]) == tg, bar);
      __builtin_amdgcn_fence(__ATOMIC_ACQUIRE, "agent");
      xb_add(&bar[XB_XGEN(b.x)], 1u);
      asm volatile("s_waitcnt vmcnt(0)" ::: "memory");
    } else {
      XB_SPIN(xb_ld(&bar[XB_XGEN(b.x)]) == gen, bar);
      __builtin_amdgcn_fence(__ATOMIC_ACQUIRE, "agent");
      asm volatile("s_waitcnt vmcnt(0)" ::: "memory");
    }
  }
  __syncthreads();
}

__global__ void __launch_bounds__(NTHREADS, 2) hybrid_fwd(Params p) {
  __shared__ __attribute__((aligned(16))) char smem[SMEM_BYTES];
  __shared__ uint4 xb_words;
  if (threadIdx.x == 0) xb_words = make_uint4(0u, 0u, 0u, 0u);
  __syncthreads();
  XcdBarrier xb{};
  bool xb_ready = false;
  for (int ph = p.phase_begin; ph < p.phase_end; ++ph) {
    if (ph == 0) phase_init0(p, smem);
    else if (ph == 1) phase_init1(p);
    else if (ph == NPHASES - 1) phase_final(p);
    else {
      const int l = (ph - 2) / NSUB, sub = (ph - 2) % NSUB;
      if (sub == 0) {
        const float* mvdummy = nullptr; (void)mvdummy;
        xn_phase(p, l > 0 ? p.stats2 : nullptr, l > 0 ? p.ln2_g + (l - 1) * 1024 : nullptr, l > 0 ? p.ln2_b + (l - 1) * 1024 : nullptr, l, 1024, 0);
        wconv_phase(p, l, smem);
      }
      else if (sub == 1) { int rt, ct; for (int i = 0; swz_tile(i, 30, rt, ct); ++i) phaseA_tile(p, l, rt * 30 + ct, smem); }
      else if (sub == 2) phaseB(p, l, smem);
      else if (sub == 3) { int rt, ct; for (int i = 0; swz_tile(i, 8, rt, ct); ++i) phaseC0_tile(p, l, (ct >= 4 ? NROWT * 4 : 0) + rt * 4 + (ct & 3), smem); }
      else if (sub == 4) { int rt, ct; for (int i = 0; swz_tile(i, 8, rt, ct); ++i) phaseC1_tile(p, l, rt * 8 + ct, smem); }
      else if (sub == 5) { int rt, ct; for (int i = 0; swz_tile(i, 8, rt, ct); ++i) phaseC2_tile(p, l, rt * 8 + ct, smem); }
      else if (sub == 6) xn_phase(p, p.stats1, p.ln1_g + l * 1024, p.ln1_b + l * 1024, l, 4096, 3072);
      else if (sub == 7) { int rt, ct; for (int i = 0; swz_tile(i, 32, rt, ct); ++i) phaseC3_tile(p, l, rt * 32 + ct, smem); }
      else { int rt, ct; for (int i = 0; swz_tile(i, 8, rt, ct); ++i) phaseC4_tile(p, l, rt * 8 + ct, smem); }
    }
    if (ph + 1 < p.phase_end) {
      if (!xb_ready) {
        cg::this_grid().sync();
        xb = xcd_barrier_post(p.bar, (volatile LAS unsigned*)&xb_words);
        xb_ready = true;
      } else {
        xcd_barrier(xb);
      }
    }
  }
}

extern "C" void kernel_launch(void* const* d_in, const int* in_sizes, int n_in, void* d_out, int out_size, void* d_ws, size_t ws_size,
                              hipStream_t stream) {
  Params p{};
  const float** pp = (const float**)&p;
  for (int i = 0; i < 40; ++i) pp[i] = (const float*)d_in[i];
  p.out = (float*)d_out;
  char* w = (char*)d_ws;
  size_t off = 0;
  auto take = [&](size_t bytes) { char* q = w + off; off += (bytes + 255) & ~(size_t)255; return q; };
  p.X = (float*)take((size_t)NTOK * 1024 * 4);
  p.P = (u16*)take((size_t)NTOK * 4096 * 2);
  p.Vt = p.P + (size_t)NTOK * PW;
  p.R2 = (u16*)take((size_t)NTOK * 1024 * 2);
  p.S5S = (u16*)take((size_t)NTOK * 512 * 2);
  p.modv = (float*)take((size_t)DEPTH * 9 * 6144 * 4);
  p.modpart = (float*)p.P;
  p.stats1 = (float*)take((size_t)NTOK * 16 * 4);
  p.stats2 = (float*)take((size_t)NTOK * 16 * 4);
  p.bonus = (float*)take((size_t)2 * NTOK * 8 * 4);
  p.rope = (float*)take(2048 * 4);
  p.ctr = (int*)take(256);
  p.bar = (unsigned*)take(XCD_BAR_WORDS * 4);
  p.cuc = (int*)take(DEPTH * 4096 * 4);
  p.WB = (u16*)d_out;
  p.XN = (u16*)((char*)d_out + (size_t)40 * 1024 * 1024);
  if (off > ws_size) { fprintf(stderr, "workspace too small: need %zu have %zu\n", off, ws_size); return; }
  static int grid_blocks = 0;
  if (!grid_blocks) {
    int dev = 0, cus = 0, per_cu = 0;
    hipGetDevice(&dev);
    hipDeviceGetAttribute(&cus, hipDeviceAttributeMultiprocessorCount, dev);
    hipOccupancyMaxActiveBlocksPerMultiprocessor(&per_cu, hybrid_fwd, NTHREADS, 0);
    if (per_cu > 2) per_cu = 2;
    grid_blocks = cus * per_cu;
  }
#if MULTI_LAUNCH
  for (int ph = 0; ph < NPHASES; ++ph) {
    p.phase_begin = ph; p.phase_end = ph + 1;
    hipLaunchKernelGGL(hybrid_fwd, dim3(grid_blocks), dim3(NTHREADS), 0, stream, p);
  }
#else
  p.phase_begin = 0; p.phase_end = NPHASES;
  void* args[] = {&p};
  hipError_t e = hipLaunchCooperativeKernel((void*)hybrid_fwd, dim3(grid_blocks), dim3(NTHREADS), args, 0, stream);
  if (e != hipSuccess) fprintf(stderr, "cooperative launch failed: %s (grid %d)\n", hipGetErrorString(e), grid_blocks);
#endif
}
```
